# Optimizing an MI355X kernel written in HIP

```python
import jax, jax.numpy as jnp
from jax import lax
import numpy as np

D_MODEL = 1024
BATCH = 4
SEQ = 4096
DEPTH = 1

CTX_LEN = 256
GRID_W = 64
HG_HEADS = 8
HG_HEAD_DIM = 128
HG_WIDTH = HG_HEADS * HG_HEAD_DIM
CONV_GROUPS = 8
CONV_WIDTH = 1024
CONV_K = 3
MIX_WIDTH = HG_WIDTH + CONV_WIDTH
HG_COLS = 5 * HG_WIDTH
CONV_COLS = 4 * CONV_WIDTH
IN_COLS = HG_COLS + CONV_COLS
CHUNK = 64
EPS = 1e-6

kernel_name = 'hymba_hgrn2_shortconv_prefix_dit'


def rmsnorm(x, w):
    xf = x.astype(jnp.float32)
    y = xf * lax.rsqrt(jnp.mean(xf * xf, axis=-1, keepdims=True) + EPS)
    return (y * w.astype(jnp.float32)).astype(x.dtype)


def to_heads(z):
    b, t, _ = z.shape
    return z.reshape(b, t, HG_HEADS, HG_HEAD_DIM).transpose(0, 2, 1, 3)


def from_heads(z):
    b, h, t, d = z.shape
    return z.transpose(0, 2, 1, 3).reshape(b, t, h * d)


def lower_bound(logits, layer):
    sm = jax.nn.softmax(logits.astype(jnp.float32), axis=0)
    return jnp.cumsum(sm, axis=0)[layer]


def chunk_scan(q, k, v, logf, s0):
    b_, h_, t_, dk = q.shape
    dv = v.shape[-1]
    n = t_ // CHUNK
    split = lambda a: a.reshape(b_, h_, n, CHUNK, a.shape[-1]).transpose(2, 0, 1, 3, 4)
    mask = jnp.tril(jnp.ones((CHUNK, CHUNK), dtype=bool))[:, :, None]

    def step(S, inp):
        qc, kc, vc, gc = inp
        bcum = jnp.cumsum(gc, axis=2)
        diff = bcum[:, :, :, None, :] - bcum[:, :, None, :, :]
        decay = jnp.where(mask, jnp.exp(jnp.where(mask, diff, 0.0)), 0.0)
        attn = jnp.einsum('bhtk,bhsk,bhtsk->bhts', qc, kc, decay)
        o = jnp.einsum('bhts,bhsv->bhtv', attn, vc) + jnp.einsum('bhtk,bhkv->bhtv', qc * jnp.exp(bcum), S)
        b_last = bcum[:, :, -1, :]
        S_new = jnp.exp(b_last)[..., None] * S + jnp.einsum(
            'bhsk,bhsv->bhkv', kc * jnp.exp(b_last[:, :, None, :] - bcum), vc)
        return S_new, o

    s_fin, os_ = lax.scan(step, s0, (split(q), split(k), split(v), split(logf)))
    o = os_.transpose(1, 2, 0, 3, 4).reshape(b_, h_, t_, dv)
    return o, s_fin


def bidir_scan(q, k_f, k_b, v, g_f, g_b, s_f, s_b):
    flip = lambda a: jnp.flip(a, axis=2)
    o_f, sf = chunk_scan(q, k_f, v, g_f, s_f)
    o_b, sb = chunk_scan(flip(q), flip(k_b), flip(v), flip(g_b), s_b)
    return o_f + flip(o_b), sf, sb


def hgrn_prep(p_hg, lb_f, lb_b):
    q, i, zf, zb = [p_hg[..., j * HG_WIDTH:(j + 1) * HG_WIDTH].astype(jnp.float32) for j in range(4)]
    f_f = lb_f + (1.0 - lb_f) * jax.nn.sigmoid(zf)
    f_b = lb_b + (1.0 - lb_b) * jax.nn.sigmoid(zb)
    return (to_heads(q), to_heads(i), to_heads(1.0 - f_f), to_heads(jnp.log(f_f)),
            to_heads(1.0 - f_b), to_heads(jnp.log(f_b)))


def hgrn_out(o, gate, onorm_w, dtype):
    o = o * lax.rsqrt(jnp.mean(o * o, axis=-1, keepdims=True) + EPS) * onorm_w.astype(jnp.float32)
    return from_heads(o).astype(dtype) * jax.nn.silu(gate)


def conv3(u, w):
    pad = [(0, 0)] * (u.ndim - 2) + [(1, 1), (0, 0)]
    up = jnp.pad(u, pad)
    return w[0] * up[..., :-2, :] + w[1] * up[..., 1:-1, :] + w[2] * up[..., 2:, :]


def conv_branch(p_cv, w, grid):
    h, bg, cg, gate = [p_cv[..., j * CONV_WIDTH:(j + 1) * CONV_WIDTH] for j in range(4)]
    u = cg * h
    if grid:
        b_, t_, ch = u.shape
        rows = t_ // GRID_W
        v = conv3(u.reshape(b_, rows, GRID_W, ch), w).reshape(b_, t_, ch)
    else:
        v = conv3(u, w)
    return bg * v * jax.nn.silu(gate)


def setup_inputs(seed: int = 0) -> dict:
    key = jax.random.key(seed)
    ks = jax.random.split(key, 13)
    f32 = jnp.float32
    x = jax.random.normal(ks[0], (BATCH, SEQ, D_MODEL), f32)
    c = jax.random.normal(ks[1], (BATCH, D_MODEL), f32)
    ctx = jax.random.normal(ks[2], (BATCH, CTX_LEN, D_MODEL), f32)
    c_ctx = jax.random.normal(ks[3], (D_MODEL,), f32)
    norm_w = 1.0 + 0.02 * jax.random.normal(ks[4], (DEPTH, D_MODEL), f32)
    w_ada = 0.5 * D_MODEL ** -0.5 * jax.random.normal(ks[5], (DEPTH, D_MODEL, 3 * D_MODEL), f32)
    b_ada = 0.02 * jax.random.normal(ks[6], (DEPTH, 3 * D_MODEL), f32)
    w_in = D_MODEL ** -0.5 * jax.random.normal(ks[7], (DEPTH, D_MODEL, IN_COLS), f32)
    hg_lb_logits = 0.1 * jax.random.normal(ks[8], (2, DEPTH + 1, HG_WIDTH), f32)
    hg_onorm_w = 1.0 + 0.02 * jax.random.normal(ks[9], (DEPTH, HG_HEAD_DIM), f32)
    conv_w = CONV_K ** -0.5 * jax.random.normal(ks[10], (DEPTH, CONV_K, CONV_WIDTH), f32)
    w_out = MIX_WIDTH ** -0.5 * jax.random.normal(ks[11], (DEPTH, MIX_WIDTH, D_MODEL), f32)
    final_norm_w = 1.0 + 0.02 * jax.random.normal(ks[12], (D_MODEL,), f32)
    return {'x': x, 'c': c, 'ctx': ctx, 'c_ctx': c_ctx, 'norm_w': norm_w, 'w_ada': w_ada,
            'b_ada': b_ada, 'w_in': w_in, 'hg_lb_logits': hg_lb_logits, 'hg_onorm_w': hg_onorm_w,
            'conv_w': conv_w, 'w_out': w_out, 'final_norm_w': final_norm_w}


def reference(x, c, ctx, c_ctx, norm_w, w_ada, b_ada, w_in, hg_lb_logits, hg_onorm_w,
              conv_w, w_out, final_norm_w):
    xc = ctx
    bsz = x.shape[0]
    for l in range(DEPTH):
        last = l == DEPTH - 1
        shift, scale, gate = jnp.split(jax.nn.silu(c) @ w_ada[l] + b_ada[l], 3, axis=-1)
        shift_c, scale_c, gate_c = jnp.split(jax.nn.silu(c_ctx) @ w_ada[l] + b_ada[l], 3, axis=-1)
        h = rmsnorm(x, norm_w[l]) * (1.0 + scale[:, None]) + shift[:, None]
        hc = rmsnorm(xc, norm_w[l]) * (1.0 + scale_c) + shift_c
        p = h @ w_in[l]
        pc = hc @ (w_in[l, :, :HG_COLS] if last else w_in[l])
        lb_f = lower_bound(hg_lb_logits[0], l)
        lb_b = lower_bound(hg_lb_logits[1], l)
        qc, vc, kcf, gcf, kcb, gcb = hgrn_prep(pc[..., :HG_COLS], lb_f, lb_b)
        s0 = jnp.zeros((bsz, HG_HEADS, HG_HEAD_DIM, HG_HEAD_DIM), jnp.float32)
        oc, s_f, s_b = bidir_scan(qc, kcf, kcb, vc, gcf, gcb, s0, s0)
        q, v, kf, gf, kb, gb = hgrn_prep(p[..., :HG_COLS], lb_f, lb_b)
        o, _, _ = bidir_scan(q, kf, kb, v, gf, gb, s_f, s_b)
        y_hg = hgrn_out(o, p[..., 4 * HG_WIDTH:HG_COLS], hg_onorm_w[l], x.dtype)
        y_cv = conv_branch(p[..., HG_COLS:], conv_w[l], grid=True)
        y = jnp.concatenate([y_hg, y_cv], axis=-1) @ w_out[l]
        if not last:
            yc_hg = hgrn_out(oc, pc[..., 4 * HG_WIDTH:HG_COLS], hg_onorm_w[l], xc.dtype)
            yc_cv = conv_branch(pc[..., HG_COLS:], conv_w[l], grid=False)
            yc = jnp.concatenate([yc_hg, yc_cv], axis=-1) @ w_out[l]
            xc = xc + gate_c * yc
        x = x + gate[:, None] * y
    return rmsnorm(x, final_norm_w)
```

```cpp
#include <hip/hip_runtime.h>
#include <hip/hip_cooperative_groups.h>
#include <cstdio>
#include <cstdint>
namespace cg = cooperative_groups;
namespace pg8 {
#define PG8_LAS __attribute__((address_space(3)))
typedef unsigned short bf16_t;
typedef short bf16x8 __attribute__((ext_vector_type(8)));
typedef float f32x4 __attribute__((ext_vector_type(4)));
typedef unsigned u32x4 __attribute__((ext_vector_type(4)));
constexpr int BM = 256, BK = 64, HALF = 128, HTB = HALF * BK * 2  , STAGE_BYTES = 8 * HTB, NXCD = 8, WGM = 8;

__host__ __device__ __forceinline__ int lds_byte(int r, int c) { const int st = (r >> 4) * 2 + (c >> 5), rr = r & 15, cc = c & 31, ob = rr * 64 + cc * 2; return st * 1024 + (ob ^ (((ob >> 9) & 1) << 5)); }
__host__ __device__ __forceinline__ void stage_rc(int b, int& R, int& C) { const int st = b / 1024, sb = b % 1024, swz = sb ^ (((sb >> 9) & 1) << 5); R = (st >> 1) * 16 + swz / 64; C = (st & 1) * 32 + (swz % 64) / 2; }
__host__ __device__ __forceinline__ int perm32(int rho) { const int n = rho >> 4, i = rho & 15; return 8 * (i >> 2) + 4 * n + (i & 3); }

struct Unit { int pm, pn; };
struct Gemm { const bf16_t* A; const bf16_t* Bt; int M, N, K; };

struct StaticOrder {
    int nM, nN, nwg, G, c;
    __host__ __device__ void init(int M, int N, int G_, int c_) { nM = M / BM; nN = N / BM; nwg = nM * nN; G = G_; c = c_; }
    __host__ __device__ bool next(int i, Unit& u) const {
        const long L = (long)i * G + c; if (L >= nwg) return false;
        int wgid = (int)L; { const int q = nwg / NXCD, r = nwg % NXCD, xcd = wgid % NXCD, off = wgid / NXCD; wgid = (xcd < r ? xcd * (q + 1) : r * (q + 1) + (xcd - r) * q) + off; }
        const int nig = WGM * nN, gid = wgid / nig, fm = gid * WGM, gsz = (nM - fm) < WGM ? (nM - fm) : WGM;
        u.pm = fm + ((wgid % nig) % gsz); u.pn = (wgid % nig) / gsz; return true;
    }
    __device__ __forceinline__ void a_ready(const Unit&) const {}
    __device__ __forceinline__ void done(const Unit&) const {}
};

__device__ __forceinline__ unsigned cvt_pk_bf16(float lo, float hi) { unsigned r; asm volatile("v_cvt_pk_bf16_f32 %0, %1, %2" : "=v"(r) : "v"(lo), "v"(hi)); return r; }
template <class Epi, class Sched, bool ALIGN_EPI = false, bool SP2 = false>
__device__ __forceinline__ void gemm_phase(PG8_LAS unsigned char* lds, const Gemm g, const Sched& S, const Epi& E) {
    const int tid = threadIdx.x, wid = __builtin_amdgcn_readfirstlane(tid >> 6), lane = tid & 63, wr = wid >> 2, wc = wid & 3, fr = lane & 15, fq = lane >> 4;
    const int K = g.K, nt = K / BK;
    unsigned voffA[2], voffB[2];
#pragma unroll
    for (int i = 0; i < 2; ++i) { int R, C; stage_rc(tid * 16 + i * 8192, R, C); const int Rb = Epi::PERM ? ((R & ~31) + perm32(R & 31)) : R;
        voffA[i] = (unsigned)(R * K + C) * 2u; voffB[i] = (unsigned)(Rb * K + C) * 2u; }
    const size_t kstep = (size_t)(BK * 2);
    const size_t hstep = (size_t)HALF * K * 2;
    const size_t tstep = 2 * hstep;
    const unsigned ldsw = (unsigned)wid * 1024u;
    const int aoff = lds_byte(wr * 64 + fr, fq * 8), boff = lds_byte(wc * 32 + fr, fq * 8);
#define PG8_SA(b, h) (((b) * 2 + (h)) * HTB)
#define PG8_SB(b, h) ((4 + (b) * 2 + (h)) * HTB)
#define PG8_STAGE(bufoff, gbase, voff) do { _Pragma("unroll") for (int _i = 0; _i < 2; ++_i) \
        __builtin_amdgcn_global_load_lds((const unsigned*)((const char*)(gbase) + (voff)[_i]), (PG8_LAS unsigned*)(lds + (bufoff) + ldsw + _i * 8192), 16, 0, 0); } while (0)
#define PG8_LDA(dst, b, h) do { _Pragma("unroll") for (int m = 0; m < 4; ++m) _Pragma("unroll") for (int k = 0; k < 2; ++k) dst[m][k] = *(const PG8_LAS bf16x8*)(lds + PG8_SA(b, h) + aoff + m * 2048 + k * 1024); } while (0)
#define PG8_LDB(dst, b, h) do { _Pragma("unroll") for (int n = 0; n < 2; ++n) _Pragma("unroll") for (int k = 0; k < 2; ++k) dst[n][k] = *(const PG8_LAS bf16x8*)(lds + PG8_SB(b, h) + boff + n * 2048 + k * 1024); } while (0)
#define PG8_MMA(ai, bj, At, Bt) do { __builtin_amdgcn_s_setprio(1); _Pragma("unroll") for (int m = 0; m < 4; ++m) _Pragma("unroll") for (int n = 0; n < 2; ++n) _Pragma("unroll") for (int k = 0; k < 2; ++k) \
        acc[ai][bj][m][n] = __builtin_amdgcn_mfma_f32_16x16x32_bf16(Bt[n][k], At[m][k], acc[ai][bj][m][n], 0, 0, 0); __builtin_amdgcn_s_setprio(0); } while (0)
#define PG8_WAIT_V(n) asm volatile("s_waitcnt vmcnt(" #n ")" ::: "memory")
#define PG8_WAIT_L(n) asm volatile("s_waitcnt lgkmcnt(" #n ")" ::: "memory")
#define PG8_BAR __builtin_amdgcn_s_barrier()
#define PG8_SCHED __builtin_amdgcn_sched_barrier(0)
    Unit cur, nxt; int ui = 0;
    if (!S.next(0, cur)) return;
    f32x4 acc[2][2][4][2];
#pragma unroll
    for (int a = 0; a < 2; ++a)
#pragma unroll
        for (int b = 0; b < 2; ++b)
#pragma unroll
            for (int m = 0; m < 4; ++m)
#pragma unroll
                for (int n = 0; n < 2; ++n) acc[a][b][m][n] = (f32x4){0.f, 0.f, 0.f, 0.f};
    bf16x8 At[4][2], B0[2][2], B1[2][2];
    const char* cA = (const char*)g.A + (size_t)cur.pm * tstep; const char* cB = (const char*)g.Bt + (size_t)cur.pn * tstep;
    S.a_ready(cur);
    if constexpr (SP2) {
        PG8_STAGE(PG8_SB(0, 0), cB, voffB); PG8_STAGE(PG8_SB(0, 1), cB + hstep, voffB); PG8_STAGE(PG8_SA(0, 0), cA, voffA); PG8_STAGE(PG8_SA(0, 1), cA + hstep, voffA);
        if (wr == 1) PG8_BAR;
        PG8_WAIT_V(2); PG8_BAR;
        PG8_STAGE(PG8_SB(1, 0), cB + kstep, voffB); PG8_STAGE(PG8_SA(1, 0), cA + kstep, voffA); PG8_STAGE(PG8_SB(1, 1), cB + hstep + kstep, voffB);
        PG8_WAIT_V(6); PG8_BAR;
    } else {
        PG8_STAGE(PG8_SB(0, 0), cB, voffB); PG8_STAGE(PG8_SA(0, 0), cA, voffA); PG8_STAGE(PG8_SB(0, 1), cB + hstep, voffB); PG8_STAGE(PG8_SA(0, 1), cA + hstep, voffA);
        if (wr == 1) PG8_BAR;
        PG8_WAIT_V(4); PG8_BAR;
        PG8_STAGE(PG8_SB(1, 0), cB + kstep, voffB); PG8_STAGE(PG8_SA(1, 0), cA + kstep, voffA); PG8_STAGE(PG8_SB(1, 1), cB + hstep + kstep, voffB);
        PG8_WAIT_V(6); PG8_BAR;
    }
    for (;;) {
        const bool has_next = S.next(ui + 1, nxt);
        const char* nA = has_next ? (const char*)g.A + (size_t)nxt.pm * tstep : cA; const char* nB = has_next ? (const char*)g.Bt + (size_t)nxt.pn * tstep : cB;
        for (int t = 0; t < nt; t += 2) {
            const bool last = (t == nt - 2);
            const char* a1 = cA + (size_t)(t + 1) * kstep;
            const char* a2 = last ? nA : cA + (size_t)(t + 2) * kstep; const char* b2 = last ? nB : cB + (size_t)(t + 2) * kstep;
            const char* a3 = a2 + kstep; const char* b3 = b2 + kstep;
            if (last && has_next) S.a_ready(nxt);
            if constexpr (SP2) {
            PG8_LDB(B0, 0, 0); PG8_LDB(B1, 0, 1); PG8_SCHED; PG8_LDA(At, 0, 0); PG8_STAGE(PG8_SA(1, 1), a1 + hstep, voffA);
            PG8_WAIT_V(8); PG8_WAIT_L(0); PG8_BAR; PG8_MMA(0, 0, At, B0); PG8_MMA(0, 1, At, B1); PG8_BAR; PG8_SCHED;
            PG8_LDA(At, 0, 1); PG8_STAGE(PG8_SB(0, 0), b2, voffB); PG8_STAGE(PG8_SB(0, 1), b2 + hstep, voffB); PG8_STAGE(PG8_SA(0, 0), a2, voffA);
            PG8_WAIT_V(8); PG8_WAIT_L(0); PG8_BAR; PG8_MMA(1, 0, At, B0); PG8_MMA(1, 1, At, B1); PG8_BAR; PG8_SCHED;
            PG8_LDB(B0, 1, 0); PG8_LDB(B1, 1, 1); PG8_SCHED; PG8_LDA(At, 1, 0); PG8_STAGE(PG8_SA(0, 1), a2 + hstep, voffA);
            PG8_WAIT_V(8); PG8_WAIT_L(0); PG8_BAR; PG8_MMA(0, 0, At, B0); PG8_MMA(0, 1, At, B1); PG8_BAR; PG8_SCHED;
            PG8_LDA(At, 1, 1); PG8_STAGE(PG8_SB(1, 0), b3, voffB); PG8_STAGE(PG8_SB(1, 1), b3 + hstep, voffB); PG8_STAGE(PG8_SA(1, 0), a3, voffA);
            PG8_WAIT_V(8); PG8_WAIT_L(0); PG8_BAR; PG8_MMA(1, 0, At, B0); PG8_MMA(1, 1, At, B1); PG8_BAR; PG8_SCHED;
            } else {
            PG8_LDB(B0, 0, 0); PG8_SCHED; PG8_LDA(At, 0, 0); PG8_STAGE(PG8_SA(1, 1), a1 + hstep, voffA);
            PG8_WAIT_L(8); PG8_BAR; PG8_WAIT_L(0); PG8_MMA(0, 0, At, B0); PG8_BAR; PG8_SCHED;
            PG8_LDB(B1, 0, 1); PG8_STAGE(PG8_SB(0, 0), b2, voffB);
            PG8_BAR; PG8_WAIT_L(0); PG8_MMA(0, 1, At, B1); PG8_BAR;
            PG8_LDA(At, 0, 1); PG8_STAGE(PG8_SA(0, 0), a2, voffA);
            PG8_BAR; PG8_WAIT_L(0); PG8_MMA(1, 0, At, B0); PG8_BAR; PG8_SCHED;
            PG8_STAGE(PG8_SB(0, 1), b2 + hstep, voffB);
            PG8_WAIT_V(6); PG8_BAR; PG8_MMA(1, 1, At, B1); PG8_BAR;
            PG8_LDB(B0, 1, 0); PG8_SCHED; PG8_LDA(At, 1, 0); PG8_STAGE(PG8_SA(0, 1), a2 + hstep, voffA);
            PG8_WAIT_L(8); PG8_BAR; PG8_WAIT_L(0); PG8_MMA(0, 0, At, B0); PG8_BAR; PG8_SCHED;
            PG8_LDB(B1, 1, 1); PG8_STAGE(PG8_SB(1, 0), b3, voffB);
            PG8_BAR; PG8_WAIT_L(0); PG8_MMA(0, 1, At, B1); PG8_BAR;
            PG8_LDA(At, 1, 1); PG8_STAGE(PG8_SA(1, 0), a3, voffA);
            PG8_BAR; PG8_WAIT_L(0); PG8_MMA(1, 0, At, B0); PG8_BAR; PG8_SCHED;
            PG8_STAGE(PG8_SB(1, 1), b3 + hstep, voffB);
            PG8_WAIT_V(6); PG8_BAR; PG8_MMA(1, 1, At, B1); PG8_BAR;
            }
        }
        if constexpr (ALIGN_EPI) { if (wr == 0) PG8_BAR; }
        if constexpr (!Epi::AFTER_DRAIN) { E(acc, cur, wr, wc, fr, fq); S.done(cur); }
        if (!has_next) break;
#pragma unroll
        for (int a = 0; a < 2; ++a)
#pragma unroll
            for (int b = 0; b < 2; ++b)
#pragma unroll
                for (int m = 0; m < 4; ++m)
#pragma unroll
                    for (int n = 0; n < 2; ++n) acc[a][b][m][n] = (f32x4){0.f, 0.f, 0.f, 0.f};
        cur = nxt; cA = nA; cB = nB; ++ui;
        if constexpr (ALIGN_EPI) { if (wr == 1) PG8_BAR; }
    }
    PG8_WAIT_V(0);
    if constexpr (!ALIGN_EPI) { if (wr == 0) PG8_BAR; }
    PG8_BAR;
    if constexpr (Epi::AFTER_DRAIN) { E.fused(acc, cur, wr, wc, fr, fq, lds, wid, lane); S.done(cur); }
#undef PG8_SA
#undef PG8_SB
#undef PG8_STAGE
#undef PG8_LDA
#undef PG8_LDB
#undef PG8_MMA
#undef PG8_WAIT_V
#undef PG8_WAIT_L
#undef PG8_BAR
#undef PG8_SCHED
}
}

#define LAS __attribute__((address_space(3)))
typedef unsigned short bf16;
typedef unsigned v4u __attribute__((ext_vector_type(4)));
typedef unsigned v2u __attribute__((ext_vector_type(2)));
typedef float f32x4 __attribute__((ext_vector_type(4)));
typedef short bf16x8 __attribute__((ext_vector_type(8)));

constexpr int DM = 1024, NB = 4, SEQ = 4096, CTXL = 256, MROWS = NB * SEQ, MCROWS = NB * CTXL, NHEAD = 8;
constexpr int N1 = 9216, MIXW = 2048;
constexpr float EPSN = 1e-6f;
constexpr size_t MiB = 1u << 20;
constexpr size_t WS_MOD = 0;
constexpr size_t WS_LB = 64 * 1024;
constexpr size_t WS_BT2 = 1 * MiB;
constexpr size_t WS_DF = 5 * MiB, WS_DB = 6 * MiB;
constexpr size_t WS_CDF = 7 * MiB, WS_CDB = 7 * MiB + 512 * 1024;
constexpr size_t WS_CKEF = 8 * MiB, WS_CKEB = 10 * MiB, WS_CV = 12 * MiB;
constexpr size_t WS_H = 14 * MiB;
constexpr size_t WS_OF = 14 * MiB;
constexpr size_t WS_HC = 46 * MiB;
constexpr size_t WS_BT1 = 48 * MiB;
constexpr size_t WS_OB = 46 * MiB;
constexpr size_t WS_YCAT = 78 * MiB;
constexpr size_t WS_QEB = 142 * MiB, WS_KEB = 174 * MiB, WS_V = 206 * MiB;
constexpr size_t WS_END = 238 * MiB;
constexpr int LDS_BYTES = 147456;

struct Params {
    const float *x, *c, *ctx, *c_ctx, *norm_w, *w_ada, *b_ada, *w_in, *lb_logits, *onorm_w, *conv_w, *w_out, *fnorm_w;
    float* out; unsigned char* ws; int ph_lo, ph_hi;
};

typedef float f32x2v __attribute__((ext_vector_type(2)));
typedef __bf16 bf16x2v __attribute__((ext_vector_type(2)));
__device__ __forceinline__ unsigned cvtpk(float lo, float hi) { const f32x2v v = {lo, hi}; return __builtin_bit_cast(unsigned, __builtin_convertvector(v, bf16x2v)); }
__device__ __forceinline__ float bf_lo(unsigned u) { return __builtin_bit_cast(float, u << 16); }
__device__ __forceinline__ float bf_hi(unsigned u) { return __builtin_bit_cast(float, u & 0xffff0000u); }
__device__ __forceinline__ float sigm(float z) { return __builtin_amdgcn_rcpf(1.0f + __builtin_amdgcn_exp2f(-1.44269504f * z)); }
__device__ __forceinline__ float wave_sum(float v) {
#pragma unroll
    for (int o = 1; o < 64; o <<= 1) v += __shfl_xor(v, o);
    return v;
}
__device__ __forceinline__ float rowscan_fwd(float x, int fr, int lane) {
#pragma unroll
    for (int d = 1; d < 16; d <<= 1) { const float y = __shfl(x, (lane - d) & 63); x = (fr >= d) ? x * y : x; }
    return x;
}
__device__ __forceinline__ float rowscan_bwd(float x, int fr, int lane) {
#pragma unroll
    for (int d = 1; d < 16; d <<= 1) { const float y = __shfl(x, (lane + d) & 63); x = (fr + d < 16) ? x * y : x; }
    return x;
}

__device__ __forceinline__ int srccol1(int np) {
    const int pn = np >> 8, c = np & 255, bj = c >> 7, wc = (c >> 5) & 3, n = (c >> 4) & 1, fq = (c >> 2) & 3, j = c & 3;
    if (pn < 16) return (bj * 2 + n) * 1024 + pn * 64 + wc * 16 + fq * 4 + j;
    if (pn < 20) return 4096 + (pn - 16) * 256 + bj * 128 + wc * 32 + fq * 8 + n * 4 + j;
    return 5120 + (bj * 2 + n) * 1024 + (pn - 20) * 64 + wc * 16 + fq * 4 + j;
}

struct Order1 {
    pg8::StaticOrder so; int G, c;
    __device__ void init(int G_, int c_) { G = G_; c = c_; so.init(MROWS, N1, 1, 0); }
    __device__ bool next(int i, pg8::Unit& u) const {
        const long L = (long)i * G + c; if (L >= 64 + 2304) return false;
        if (L < 64) { u.pm = 64 + (int)(L >> 4); u.pn = (int)(L & 15); return true; }
        pg8::StaticOrder t = so; t.G = 1; t.c = (int)(L - 64); return t.next(0, u);
    }
    __device__ __forceinline__ void a_ready(const pg8::Unit&) const {}
    __device__ __forceinline__ void done(const pg8::Unit&) const {}
};

struct Epi1 {
    static constexpr bool PERM = false, AFTER_DRAIN = false;
    const float* LB; const float* conv_w;
    bf16 *QEF, *KEF, *QEB, *KEB, *V, *CKEF, *CKEB, *CV, *YCAT; float *DF, *DB, *CDF, *CDB;
    __device__ __forceinline__ void operator()(const f32x4 (&acc)[2][2][4][2], const pg8::Unit& u, int wr, int wc, int fr, int fq) const {
        const int lane = fq * 16 + fr;
        if (u.pn < 16) {
            const bool ctx = u.pm >= 64;
            const int TT = ctx ? CTXL : SEQ, NC = TT >> 6;
            const int row_base = ctx ? (u.pm - 64) * 256 : u.pm * 256;
            const int h = u.pn >> 1, kk0 = (u.pn & 1) * 64 + wc * 16 + fq * 4, ch0 = h * 128 + kk0;
            const f32x4 lbf = *(const f32x4*)(LB + ch0), lbb = *(const f32x4*)(LB + 1024 + ch0);
            bf16* pkf = ctx ? CKEF : KEF; bf16* pkb = ctx ? CKEB : KEB; bf16* pv = ctx ? CV : V;
            float* pdf = ctx ? CDF : DF; float* pdb = ctx ? CDB : DB;
#pragma unroll
            for (int ai = 0; ai < 2; ++ai) {
                const int rb = row_base + ai * 128 + wr * 64;
                const int b = rb / TT, T0 = rb - b * TT, chunk = T0 >> 6;
                const size_t tok0 = (size_t)(b * 8 + h) * TT + T0;
                const size_t doff = ((size_t)(b * 8 + h) * NC + chunk) * 128 + kk0;
                float qf[4][4], kf[4][4], qb[4][4], kb[4][4];
#pragma unroll
                for (int j = 0; j < 4; ++j) {
                    float f[4], g[4];
#pragma unroll
                    for (int m = 0; m < 4; ++m) {
                        f[m] = (1.0f - lbf[j]) * (1.0f - sigm(acc[ai][1][m][0][j]));
                        g[m] = (1.0f - lbb[j]) * (1.0f - sigm(acc[ai][1][m][1][j]));
                    }
                    float carry = 1.0f;
#pragma unroll
                    for (int m = 0; m < 4; ++m) {
                        const float sc = rowscan_fwd(1.0f - f[m], fr, lane); const float tot = __shfl(sc, lane | 15);
                        const float P = fmaxf(sc * carry, 1e-30f); carry *= tot;
                        const float q = acc[ai][0][m][0][j]; qf[m][j] = q * P; kf[m][j] = f[m] * __builtin_amdgcn_rcpf(P);
                    }
                    if (fr == 0) pdf[doff + j] = carry;
                    carry = 1.0f;
#pragma unroll
                    for (int m = 3; m >= 0; --m) {
                        const float sc = rowscan_bwd(1.0f - g[m], fr, lane); const float tot = __shfl(sc, lane & 48);
                        const float P = fmaxf(sc * carry, 1e-30f); carry *= tot;
                        const float q = acc[ai][0][m][0][j]; qb[m][j] = q * P; kb[m][j] = g[m] * __builtin_amdgcn_rcpf(P);
                    }
                    if (fr == 0) pdb[doff + j] = carry;
                }
#pragma unroll
                for (int m = 0; m < 4; ++m) {
                    const size_t off = (tok0 + 16 * m + fr) * 128 + kk0;
                    v2u w;
                    if (!ctx) { w.x = cvtpk(qf[m][0], qf[m][1]); w.y = cvtpk(qf[m][2], qf[m][3]); *(v2u*)(QEF + off) = w;
                                w.x = cvtpk(qb[m][0], qb[m][1]); w.y = cvtpk(qb[m][2], qb[m][3]); *(v2u*)(QEB + off) = w; }
                    w.x = cvtpk(kf[m][0], kf[m][1]); w.y = cvtpk(kf[m][2], kf[m][3]); *(v2u*)(pkf + off) = w;
                    w.x = cvtpk(kb[m][0], kb[m][1]); w.y = cvtpk(kb[m][2], kb[m][3]); *(v2u*)(pkb + off) = w;
                    const f32x4 vv = acc[ai][0][m][1];
                    w.x = cvtpk(vv[0], vv[1]); w.y = cvtpk(vv[2], vv[3]); *(v2u*)(pv + off) = w;
                }
            }
        } else if (u.pn < 20) {
            const int col0 = (u.pn - 16) * 256 + wc * 32 + fq * 8;
#pragma unroll
            for (int ai = 0; ai < 2; ++ai)
#pragma unroll
                for (int m = 0; m < 4; ++m) {
                    const size_t r = (size_t)u.pm * 256 + ai * 128 + wr * 64 + 16 * m + fr;
#pragma unroll
                    for (int bj = 0; bj < 2; ++bj) {
                        const f32x4 a0 = acc[ai][bj][m][0], a1 = acc[ai][bj][m][1];
                        v4u w;
                        w.x = cvtpk(a0[0] * sigm(a0[0]), a0[1] * sigm(a0[1])); w.y = cvtpk(a0[2] * sigm(a0[2]), a0[3] * sigm(a0[3]));
                        w.z = cvtpk(a1[0] * sigm(a1[0]), a1[1] * sigm(a1[1])); w.w = cvtpk(a1[2] * sigm(a1[2]), a1[3] * sigm(a1[3]));
                        *(v4u*)(YCAT + r * MIXW + col0 + bj * 128) = w;
                    }
                }
        } else {
            const int ch0 = (u.pn - 20) * 64 + wc * 16 + fq * 4;
            const f32x4 cw0 = *(const f32x4*)(conv_w + ch0), cw1 = *(const f32x4*)(conv_w + 1024 + ch0), cw2 = *(const f32x4*)(conv_w + 2048 + ch0);
            const int src_prev = (fr == 0) ? lane + 15 : lane - 1, src_next = (fr == 15) ? lane - 15 : lane + 1;
#pragma unroll
            for (int ai = 0; ai < 2; ++ai) {
                float y[4][4];
#pragma unroll
                for (int j = 0; j < 4; ++j) {
                    float uu[4];
#pragma unroll
                    for (int m = 0; m < 4; ++m) uu[m] = acc[ai][1][m][0][j] * acc[ai][0][m][0][j];
#pragma unroll
                    for (int m = 0; m < 4; ++m) {
                        const float um1 = (m > 0) ? uu[m > 0 ? m - 1 : 0] : 0.0f, up1 = (m < 3) ? uu[m < 3 ? m + 1 : 3] : 0.0f;
                        const float prev = __shfl((fr == 15) ? um1 : uu[m], src_prev);
                        const float next = __shfl((fr == 0) ? up1 : uu[m], src_next);
                        const float cv = cw0[j] * prev + cw1[j] * uu[m] + cw2[j] * next;
                        const float gt = acc[ai][1][m][1][j];
                        y[m][j] = acc[ai][0][m][1][j] * cv * (gt * sigm(gt));
                    }
                }
#pragma unroll
                for (int m = 0; m < 4; ++m) {
                    const size_t r = (size_t)u.pm * 256 + ai * 128 + wr * 64 + 16 * m + fr;
                    v2u w; w.x = cvtpk(y[m][0], y[m][1]); w.y = cvtpk(y[m][2], y[m][3]);
                    *(v2u*)(YCAT + r * MIXW + 1024 + ch0) = w;
                }
            }
        }
    }
};

struct Epi2 {
    static constexpr bool PERM = false, AFTER_DRAIN = false;
    const float* x; const float* MOD; float* out;
    __device__ __forceinline__ void operator()(const f32x4 (&acc)[2][2][4][2], const pg8::Unit& u, int wr, int wc, int fr, int fq) const {
        const int col0 = u.pn * 256 + wc * 32 + 4 * fq; const int b = (u.pm * 256) >> 12;
        f32x4 gv[2][2];
#pragma unroll
        for (int bj = 0; bj < 2; ++bj)
#pragma unroll
            for (int n = 0; n < 2; ++n) gv[bj][n] = *(const f32x4*)(MOD + b * 3072 + 2048 + col0 + bj * 128 + n * 16);
#pragma unroll
        for (int ai = 0; ai < 2; ++ai)
#pragma unroll
            for (int m = 0; m < 4; ++m) {
                const size_t off = ((size_t)u.pm * 256 + ai * 128 + wr * 64 + 16 * m + fr) * DM + col0;
#pragma unroll
                for (int bj = 0; bj < 2; ++bj)
#pragma unroll
                    for (int n = 0; n < 2; ++n) {
                        const f32x4 xv = *(const f32x4*)(x + off + bj * 128 + n * 16);
                        *(f32x4*)(out + off + bj * 128 + n * 16) = xv + gv[bj][n] * acc[ai][bj][m][n];
                    }
            }
    }
};

template <bool MAP>
__device__ __forceinline__ void p0_transpose_item(const float* W, int K, int N, bf16* WT, LAS float* scr, int item, int lane, int nblk) {
    const int kb = item / nblk, nb = item % nblk, k0 = 64 * kb, n0 = 32 * nb;
    const int sc = MAP ? srccol1(n0 + (lane & 31)) : n0 + (lane & 31);
#pragma unroll 8
    for (int i = 0; i < 32; ++i) { const int kk = 2 * i + (lane >> 5); scr[kk * 33 + (lane & 31)] = W[(size_t)(k0 + kk) * N + sc]; }
    asm volatile("s_waitcnt lgkmcnt(0)" ::: "memory");
    const int c = lane & 7;
#pragma unroll
    for (int j = 0; j < 4; ++j) { const int n = (lane >> 3) + 8 * j; const LAS float* s = scr + (8 * c) * 33 + n;
        v4u o; o.x = cvtpk(s[0 * 33], s[1 * 33]); o.y = cvtpk(s[2 * 33], s[3 * 33]); o.z = cvtpk(s[4 * 33], s[5 * 33]); o.w = cvtpk(s[6 * 33], s[7 * 33]);
        *(v4u*)(WT + (size_t)(n0 + n) * K + k0 + 8 * c) = o; }
    asm volatile("s_waitcnt lgkmcnt(0)" ::: "memory");
}

__device__ __forceinline__ void p0_gemv(const Params& P, LAS unsigned char* lds, int nb, int tid, int wave, int lane) {
    LAS float* sil = (LAS float*)lds;
    LAS float* red = sil + 5120;
    for (int i = tid; i < 5120; i += 512) { const int v = i >> 10, k = i & 1023; const float cc = (v < 4) ? P.c[v * 1024 + k] : P.c_ctx[k]; sil[i] = cc * sigm(cc); }
    __syncthreads();
    const int kh = lane >> 5, col = lane & 31, n0 = nb * 32;
    float a0 = 0.f, a1 = 0.f, a2 = 0.f, a3 = 0.f, a4 = 0.f;
#pragma unroll 8
    for (int i = 0; i < 64; ++i) {
        const int k = 128 * wave + 2 * i + kh; const float wv = P.w_ada[(size_t)k * 3072 + n0 + col];
        a0 += sil[k] * wv; a1 += sil[1024 + k] * wv; a2 += sil[2048 + k] * wv; a3 += sil[3072 + k] * wv; a4 += sil[4096 + k] * wv;
    }
    a0 += __shfl_xor(a0, 32); a1 += __shfl_xor(a1, 32); a2 += __shfl_xor(a2, 32); a3 += __shfl_xor(a3, 32); a4 += __shfl_xor(a4, 32);
    if (lane < 32) { red[(wave * 5 + 0) * 32 + col] = a0; red[(wave * 5 + 1) * 32 + col] = a1; red[(wave * 5 + 2) * 32 + col] = a2; red[(wave * 5 + 3) * 32 + col] = a3; red[(wave * 5 + 4) * 32 + col] = a4; }
    __syncthreads();
    if (tid < 160) { const int v = tid >> 5, cl = tid & 31; float s = P.b_ada[n0 + cl];
#pragma unroll
        for (int w = 0; w < 8; ++w) s += red[(w * 5 + v) * 32 + cl];
        ((float*)(P.ws + WS_MOD))[v * 3072 + n0 + cl] = s; }
    __syncthreads();
}

constexpr int SC_QE = 0, SC_KE = 17408, SC_KET = 34816, SC_VT = 53248, SC_DD = 57856, SC_BUF = 58368;
constexpr int SROW = 272, TROW = 144;

struct ScanRegs { v4u q0, q1, k0, k1, vv; float d; };

__device__ __forceinline__ void scan_load(ScanRegs& R, const bf16* qe, const bf16* ke, const bf16* v, const float* D, bool has_q, int tid, int vs) {
    const int row = tid & 63, kc = tid >> 6;
    if (has_q) { R.q0 = *(const v4u*)(qe + row * 128 + kc * 8); R.q1 = *(const v4u*)(qe + row * 128 + (kc + 8) * 8); }
    R.k0 = *(const v4u*)(ke + row * 128 + kc * 8); R.k1 = *(const v4u*)(ke + row * 128 + (kc + 8) * 8);
    if (tid < 256) R.vv = *(const v4u*)(v + (tid & 63) * 128 + vs * 32 + (tid >> 6) * 8);
    if (tid < 128) R.d = D[tid];
}
__device__ __forceinline__ void st16x8_T(LAS unsigned char* base, int rowstride, int r0, int col, v4u w) {
    LAS unsigned short* p = (LAS unsigned short*)(base + r0 * rowstride + col * 2);
    const int rs = rowstride >> 1;
    p[0 * rs] = (unsigned short)(w.x & 0xffff); p[1 * rs] = (unsigned short)(w.x >> 16);
    p[2 * rs] = (unsigned short)(w.y & 0xffff); p[3 * rs] = (unsigned short)(w.y >> 16);
    p[4 * rs] = (unsigned short)(w.z & 0xffff); p[5 * rs] = (unsigned short)(w.z >> 16);
    p[6 * rs] = (unsigned short)(w.w & 0xffff); p[7 * rs] = (unsigned short)(w.w >> 16);
}
__device__ __forceinline__ void scan_store(const ScanRegs& R, LAS unsigned char* buf, bool has_q, int tid) {
    const int row = tid & 63, kc = tid >> 6;
    if (has_q) { *(LAS v4u*)(buf + SC_QE + row * SROW + kc * 16) = R.q0; *(LAS v4u*)(buf + SC_QE + row * SROW + (kc + 8) * 16) = R.q1; }
    *(LAS v4u*)(buf + SC_KE + row * SROW + kc * 16) = R.k0; *(LAS v4u*)(buf + SC_KE + row * SROW + (kc + 8) * 16) = R.k1;
    st16x8_T(buf + SC_KET, TROW, kc * 8, row, R.k0); st16x8_T(buf + SC_KET, TROW, (kc + 8) * 8, row, R.k1);
    if (tid < 256) st16x8_T(buf + SC_VT, TROW, (tid >> 6) * 8, tid & 63, R.vv);
    if (tid < 128) *(LAS float*)(buf + SC_DD + tid * 4) = R.d;
}
__device__ __forceinline__ bf16x8 ld2x64(const LAS unsigned char* p) {
    const v2u a = *(const LAS v2u*)p, b = *(const LAS v2u*)(p + 32);
    v4u w; w.x = a.x; w.y = a.y; w.z = b.x; w.w = b.y; return __builtin_bit_cast(bf16x8, w);
}

__device__ __forceinline__ void scan_phase(const Params& P, LAS unsigned char* lds, int tid, int wave, int lane) {
    const int fr = lane & 15, fq = lane >> 4, tb = wave >> 1, vb = wave & 1;
    unsigned char* ws = P.ws;
    for (int item = blockIdx.x; item < 256; item += gridDim.x) {
        const int xcd = item & 7, idx = item >> 3, seq = xcd * 8 + (idx >> 2), vs = idx & 3, dir = seq & 1, h = (seq >> 1) & 7, b = seq >> 4;
        const int bh = b * 8 + h;
        const bf16* qe_base = (dir ? (const bf16*)(ws + WS_QEB) : (const bf16*)P.out) + (size_t)bh * SEQ * 128;
        const bf16* ke_base = (dir ? (const bf16*)(ws + WS_KEB) : (const bf16*)P.out + (size_t)16 * MiB) + (size_t)bh * SEQ * 128;
        const bf16* v_base = (const bf16*)(ws + WS_V) + (size_t)bh * SEQ * 128;
        const float* d_base = (const float*)(ws + (dir ? WS_DB : WS_DF)) + (size_t)bh * 64 * 128;
        const bf16* cke_base = (const bf16*)(ws + (dir ? WS_CKEB : WS_CKEF)) + (size_t)bh * CTXL * 128;
        const bf16* cv_base = (const bf16*)(ws + WS_CV) + (size_t)bh * CTXL * 128;
        const float* cd_base = (const float*)(ws + (dir ? WS_CDB : WS_CDF)) + (size_t)bh * 4 * 128;
        bf16* o_base = (bf16*)(ws + (dir ? WS_OB : WS_OF)) + (size_t)b * SEQ * DM + h * 128 + vs * 32 + vb * 16 + fq * 4;
        f32x4 S[8];
#pragma unroll
        for (int kb = 0; kb < 8; ++kb) S[kb] = (f32x4){0.f, 0.f, 0.f, 0.f};
        constexpr int NSTEP = 68;
        ScanRegs R;
#define SCAN_LOAD(step) do { const int _s = (step); if (_s < 4) { const int cc = dir ? 3 - _s : _s; \
            scan_load(R, cke_base, cke_base + (size_t)cc * 64 * 128, cv_base + (size_t)cc * 64 * 128, cd_base + cc * 128, false, tid, vs); } \
          else { const int lc = dir ? 63 - (_s - 4) : (_s - 4); \
            scan_load(R, qe_base + (size_t)lc * 64 * 128, ke_base + (size_t)lc * 64 * 128, v_base + (size_t)lc * 64 * 128, d_base + lc * 128, true, tid, vs); } } while (0)
        SCAN_LOAD(0);
        scan_store(R, lds, false, tid);
        SCAN_LOAD(1);
        __syncthreads();
        for (int step = 0; step < NSTEP; ++step) {
            LAS unsigned char* buf = lds + (step & 1) * SC_BUF;
            LAS unsigned char* nbuf = lds + ((step + 1) & 1) * SC_BUF;
            if (step + 1 < NSTEP) scan_store(R, nbuf, step + 1 >= 4, tid);
            if (step + 2 < NSTEP) SCAN_LOAD(step + 2);
            const bool lat = step >= 4;
            if (lat) {
                const int lc = dir ? 63 - (step - 4) : (step - 4);
                bf16x8 qfr[4];
#pragma unroll
                for (int kk = 0; kk < 4; ++kk) qfr[kk] = *(const LAS bf16x8*)(buf + SC_QE + (tb * 16 + fr) * SROW + (kk * 32 + fq * 8) * 2);
                f32x4 At[4];
#pragma unroll
                for (int sb = 0; sb < 4; ++sb) {
                    At[sb] = (f32x4){0.f, 0.f, 0.f, 0.f};
                    const bool need = dir ? (sb >= tb) : (sb <= tb);
                    if (need) {
#pragma unroll
                        for (int kk = 0; kk < 4; ++kk) {
                            const bf16x8 kfr = *(const LAS bf16x8*)(buf + SC_KE + (sb * 16 + fr) * SROW + (kk * 32 + fq * 8) * 2);
                            At[sb] = __builtin_amdgcn_mfma_f32_16x16x32_bf16(kfr, qfr[kk], At[sb], 0, 0, 0);
                        }
                        if (sb == tb) {
#pragma unroll
                            for (int j = 0; j < 4; ++j) { const bool keep = dir ? (4 * fq + j >= fr) : (4 * fq + j <= fr); At[sb][j] = keep ? At[sb][j] : 0.f; }
                        }
                    }
                }
                f32x4 o = (f32x4){0.f, 0.f, 0.f, 0.f};
#pragma unroll
                for (int p = 0; p < 2; ++p) {
                    const bool need = dir ? (2 * p + 1 >= tb) : (2 * p <= tb);
                    if (need) {
                        v4u w; w.x = cvtpk(At[2 * p][0], At[2 * p][1]); w.y = cvtpk(At[2 * p][2], At[2 * p][3]); w.z = cvtpk(At[2 * p + 1][0], At[2 * p + 1][1]); w.w = cvtpk(At[2 * p + 1][2], At[2 * p + 1][3]);
                        const bf16x8 vfr = ld2x64(buf + SC_VT + (vb * 16 + fr) * TROW + (32 * p + 4 * fq) * 2);
                        o = __builtin_amdgcn_mfma_f32_16x16x32_bf16(vfr, __builtin_bit_cast(bf16x8, w), o, 0, 0, 0);
                    }
                }
#pragma unroll
                for (int kk = 0; kk < 4; ++kk) {
                    v4u w; w.x = cvtpk(S[2 * kk][0], S[2 * kk][1]); w.y = cvtpk(S[2 * kk][2], S[2 * kk][3]); w.z = cvtpk(S[2 * kk + 1][0], S[2 * kk + 1][1]); w.w = cvtpk(S[2 * kk + 1][2], S[2 * kk + 1][3]);
                    const bf16x8 qT = ld2x64(buf + SC_QE + (tb * 16 + fr) * SROW + (32 * kk + 4 * fq) * 2);
                    o = __builtin_amdgcn_mfma_f32_16x16x32_bf16(__builtin_bit_cast(bf16x8, w), qT, o, 0, 0, 0);
                }
                v2u ow; ow.x = cvtpk(o[0], o[1]); ow.y = cvtpk(o[2], o[3]);
                *(v2u*)(o_base + (size_t)(lc * 64 + tb * 16 + fr) * DM) = ow;
            }
            {
                bf16x8 vfr[2];
#pragma unroll
                for (int ss = 0; ss < 2; ++ss) vfr[ss] = *(const LAS bf16x8*)(buf + SC_VT + (vb * 16 + fr) * TROW + (ss * 32 + fq * 8) * 2);
#pragma unroll
                for (int kb = 0; kb < 8; ++kb) {
#pragma unroll
                    for (int ss = 0; ss < 2; ++ss) {
                        const bf16x8 kt = *(const LAS bf16x8*)(buf + SC_KET + (kb * 16 + fr) * TROW + (ss * 32 + fq * 8) * 2);
                        S[kb] = __builtin_amdgcn_mfma_f32_16x16x32_bf16(kt, vfr[ss], S[kb], 0, 0, 0);
                    }
                    const f32x4 dk = *(const LAS f32x4*)(buf + SC_DD + (kb * 16 + fq * 4) * 4);
                    S[kb] = S[kb] * dk;
                }
            }
            __syncthreads();
        }
#undef SCAN_LOAD
    }
}

__global__ void __launch_bounds__(512, 2) fwd_megakernel(Params P) {
    extern __shared__ __attribute__((aligned(16))) unsigned char lds_raw[];
    LAS unsigned char* lds = (LAS unsigned char*)lds_raw;
    cg::grid_group grid = cg::this_grid();
#define GRID_SYNC() do { asm volatile("s_waitcnt vmcnt(0) lgkmcnt(0)" ::: "memory"); __syncthreads(); if (tid < 64) asm volatile("buffer_wbl2 sc1\n\ts_waitcnt vmcnt(0)" ::: "memory"); grid.sync(); asm volatile("s_waitcnt vmcnt(0)" ::: "memory"); __syncthreads(); } while (0)
    const int tid = threadIdx.x, lane = tid & 63, wave = __builtin_amdgcn_readfirstlane(tid >> 6);
    const int G = gridDim.x, gw = blockIdx.x * 8 + wave, NGW = G * 8;
    unsigned char* ws = P.ws;
    float* MOD = (float*)(ws + WS_MOD); float* LB = (float*)(ws + WS_LB);

#define IN(k) (P.ph_lo <= (k) && (k) < P.ph_hi)
#define SEAM(k) do { if (IN(k) && IN((k) + 1)) GRID_SYNC(); } while (0)
    if (IN(0)) {
    if (blockIdx.x == G - 1) {
        for (int i = tid; i < 2048; i += 512) { const int d = i >> 10, ch = i & 1023; const float l0 = P.lb_logits[d * 2048 + ch], l1 = P.lb_logits[d * 2048 + 1024 + ch];
            LB[i] = 1.0f / (1.0f + __expf(l1 - l0)); }
    }
    for (int nb = blockIdx.x; nb < 96; nb += G) p0_gemv(P, lds, nb, tid, wave, lane);
    {
        LAS float* scr = (LAS float*)(lds + wave * 16384);
        constexpr int I1 = (DM / 64) * (N1 / 32), I2 = (MIXW / 64) * (DM / 32);
        for (int it = gw; it < I1 + I2; it += NGW) {
            if (it < I1) p0_transpose_item<true>(P.w_in, DM, N1, (bf16*)(ws + WS_BT1), scr, it, lane, N1 / 32);
            else p0_transpose_item<false>(P.w_out, MIXW, DM, (bf16*)(ws + WS_BT2), scr, it - I1, lane, DM / 32);
        }
    }
    }
    SEAM(0);

    if (IN(1))
    for (int r = gw; r < MROWS + MCROWS; r += NGW) {
        const bool isx = r < MROWS; const int v = isx ? (r >> 12) : 4;
        const float* xr = isx ? P.x + (size_t)r * DM : P.ctx + (size_t)(r - MROWS) * DM;
        bf16* orow = (bf16*)(ws + WS_H) + (size_t)r * DM;
        f32x4 xv[4]; float s = 0.f;
#pragma unroll
        for (int j = 0; j < 4; ++j) { xv[j] = *(const f32x4*)(xr + 4 * lane + 256 * j); s += (xv[j][0] * xv[j][0] + xv[j][1] * xv[j][1]) + (xv[j][2] * xv[j][2] + xv[j][3] * xv[j][3]); }
        const float rstd = 1.0f / sqrtf(wave_sum(s) * (1.0f / DM) + EPSN);
#pragma unroll
        for (int j = 0; j < 4; ++j) {
            const int c0 = 4 * lane + 256 * j;
            const f32x4 nw = *(const f32x4*)(P.norm_w + c0), sh = *(const f32x4*)(MOD + v * 3072 + c0), sc = *(const f32x4*)(MOD + v * 3072 + 1024 + c0);
            const f32x4 hv = (xv[j] * rstd) * nw * (sc + 1.0f) + sh;
            v2u w; w.x = cvtpk(hv[0], hv[1]); w.y = cvtpk(hv[2], hv[3]);
            *(v2u*)(orow + c0) = w;
        }
    }
    SEAM(1);

    if (IN(2)) {
        pg8::Gemm g{(const pg8::bf16_t*)(ws + WS_H), (const pg8::bf16_t*)(ws + WS_BT1), MROWS + MCROWS, N1, DM};
        Order1 S; S.init(G, (int)blockIdx.x);
        Epi1 E{LB, P.conv_w, (bf16*)P.out, (bf16*)P.out + (size_t)16 * MiB, (bf16*)(ws + WS_QEB), (bf16*)(ws + WS_KEB), (bf16*)(ws + WS_V),
               (bf16*)(ws + WS_CKEF), (bf16*)(ws + WS_CKEB), (bf16*)(ws + WS_CV), (bf16*)(ws + WS_YCAT),
               (float*)(ws + WS_DF), (float*)(ws + WS_DB), (float*)(ws + WS_CDF), (float*)(ws + WS_CDB)};
        pg8::gemm_phase<Epi1, Order1, false, true>(lds, g, S, E);
    }
    SEAM(2);

    if (IN(3)) scan_phase(P, lds, tid, wave, lane);
    SEAM(3);

    if (IN(4))
    for (int r = gw; r < MROWS; r += NGW) {
        const bf16* of = (const bf16*)(ws + WS_OF) + (size_t)r * DM + 16 * lane;
        const bf16* ob = (const bf16*)(ws + WS_OB) + (size_t)r * DM + 16 * lane;
        bf16* yc = (bf16*)(ws + WS_YCAT) + (size_t)r * MIXW + 16 * lane;
        const v4u f0 = *(const v4u*)of, f1 = *(const v4u*)(of + 8), b0 = *(const v4u*)ob, b1 = *(const v4u*)(ob + 8), g0 = *(const v4u*)yc, g1 = *(const v4u*)(yc + 8);
        float sv[16];
        sv[0] = bf_lo(f0.x) + bf_lo(b0.x); sv[1] = bf_hi(f0.x) + bf_hi(b0.x); sv[2] = bf_lo(f0.y) + bf_lo(b0.y); sv[3] = bf_hi(f0.y) + bf_hi(b0.y);
        sv[4] = bf_lo(f0.z) + bf_lo(b0.z); sv[5] = bf_hi(f0.z) + bf_hi(b0.z); sv[6] = bf_lo(f0.w) + bf_lo(b0.w); sv[7] = bf_hi(f0.w) + bf_hi(b0.w);
        sv[8] = bf_lo(f1.x) + bf_lo(b1.x); sv[9] = bf_hi(f1.x) + bf_hi(b1.x); sv[10] = bf_lo(f1.y) + bf_lo(b1.y); sv[11] = bf_hi(f1.y) + bf_hi(b1.y);
        sv[12] = bf_lo(f1.z) + bf_lo(b1.z); sv[13] = bf_hi(f1.z) + bf_hi(b1.z); sv[14] = bf_lo(f1.w) + bf_lo(b1.w); sv[15] = bf_hi(f1.w) + bf_hi(b1.w);
#if defined(DBG) && DBG == 3
        { const int bb = r >> 12, TT_ = r & 4095, hh = lane >> 3, k0 = (16 * lane) & 127;
          const size_t qo = ((size_t)(bb * 8 + hh) * 4096 + TT_) * 128 + k0;
          const bf16* a0 = (const bf16*)P.out + qo; const bf16* a1 = (const bf16*)P.out + (size_t)16 * MiB + qo;
          const bf16* a2 = (const bf16*)(ws + WS_QEB) + qo; const bf16* a3 = (const bf16*)(ws + WS_KEB) + qo; const bf16* a4 = (const bf16*)(ws + WS_V) + qo;
          const float* d0 = (const float*)(ws + WS_DF) + ((size_t)(bb * 8 + hh) * 64 + (TT_ >> 6)) * 128 + k0; const float* d1 = (const float*)(ws + WS_DB) + ((size_t)(bb * 8 + hh) * 64 + (TT_ >> 6)) * 128 + k0;
#pragma unroll
          for (int e = 0; e < 16; ++e) sv[e] = bf_lo(a0[e]) + 1e-3f * fminf(bf_lo(a1[e]), 1e3f) + bf_lo(a2[e]) + 1e-3f * fminf(bf_lo(a3[e]), 1e3f) + bf_lo(a4[e]) + d0[e] + d1[e]; }
#endif
#if defined(DBG) && DBG == 1
#pragma unroll
        for (int e = 0; e < 16; ++e) sv[e] = 0.25f;
#endif
        float ss = 0.f;
#pragma unroll
        for (int e = 0; e < 16; ++e) ss += sv[e] * sv[e];
        ss += __shfl_xor(ss, 1); ss += __shfl_xor(ss, 2); ss += __shfl_xor(ss, 4);
        const float rs = 1.0f / sqrtf(ss * (1.0f / 128.0f) + EPSN);
        const float* owp = P.onorm_w + ((16 * lane) & 127);
        const f32x4 w0 = *(const f32x4*)owp, w1 = *(const f32x4*)(owp + 4), w2 = *(const f32x4*)(owp + 8), w3 = *(const f32x4*)(owp + 12);
        float gt[16];
        gt[0] = bf_lo(g0.x); gt[1] = bf_hi(g0.x); gt[2] = bf_lo(g0.y); gt[3] = bf_hi(g0.y); gt[4] = bf_lo(g0.z); gt[5] = bf_hi(g0.z); gt[6] = bf_lo(g0.w); gt[7] = bf_hi(g0.w);
        gt[8] = bf_lo(g1.x); gt[9] = bf_hi(g1.x); gt[10] = bf_lo(g1.y); gt[11] = bf_hi(g1.y); gt[12] = bf_lo(g1.z); gt[13] = bf_hi(g1.z); gt[14] = bf_lo(g1.w); gt[15] = bf_hi(g1.w);
        float yv[16];
#pragma unroll
        for (int e = 0; e < 4; ++e) { yv[e] = sv[e] * rs * w0[e] * gt[e]; yv[4 + e] = sv[4 + e] * rs * w1[e] * gt[4 + e]; yv[8 + e] = sv[8 + e] * rs * w2[e] * gt[8 + e]; yv[12 + e] = sv[12 + e] * rs * w3[e] * gt[12 + e]; }
        v4u o0, o1;
        o0.x = cvtpk(yv[0], yv[1]); o0.y = cvtpk(yv[2], yv[3]); o0.z = cvtpk(yv[4], yv[5]); o0.w = cvtpk(yv[6], yv[7]);
        o1.x = cvtpk(yv[8], yv[9]); o1.y = cvtpk(yv[10], yv[11]); o1.z = cvtpk(yv[12], yv[13]); o1.w = cvtpk(yv[14], yv[15]);
        *(v4u*)yc = o0; *(v4u*)(yc + 8) = o1;
    }
    SEAM(4);

    if (IN(5)) {
        pg8::Gemm g{(const pg8::bf16_t*)(ws + WS_YCAT), (const pg8::bf16_t*)(ws + WS_BT2), MROWS, DM, MIXW};
        pg8::StaticOrder S; S.init(MROWS, DM, G, (int)blockIdx.x);
        Epi2 E{P.x, MOD, P.out};
        pg8::gemm_phase<Epi2, pg8::StaticOrder, false, true>(lds, g, S, E);
    }
    SEAM(5);

    if (IN(6))
    for (int r = gw; r < MROWS; r += NGW) {
        float* orow = P.out + (size_t)r * DM;
        f32x4 xv[4]; float s = 0.f;
#pragma unroll
        for (int j = 0; j < 4; ++j) { xv[j] = *(const f32x4*)(orow + 4 * lane + 256 * j); s += (xv[j][0] * xv[j][0] + xv[j][1] * xv[j][1]) + (xv[j][2] * xv[j][2] + xv[j][3] * xv[j][3]); }
        const float rstd = 1.0f / sqrtf(wave_sum(s) * (1.0f / DM) + EPSN);
#pragma unroll
        for (int j = 0; j < 4; ++j) { const f32x4 fw = *(const f32x4*)(P.fnorm_w + 4 * lane + 256 * j); *(f32x4*)(orow + 4 * lane + 256 * j) = (xv[j] * rstd) * fw; }
    }
}

extern "C" void kernel_launch(void* const* d_in, const int* in_sizes, int n_in, void* d_out, int out_size, void* d_ws, size_t ws_size, hipStream_t stream) {
    static int grid = 0;
    if (grid == 0) {
        int dev = 0, cus = 0, per_cu = 0;
        hipGetDevice(&dev); hipDeviceGetAttribute(&cus, hipDeviceAttributeMultiprocessorCount, dev);
        if (hipFuncSetAttribute((const void*)fwd_megakernel, hipFuncAttributeMaxDynamicSharedMemorySize, LDS_BYTES) != hipSuccess) { fprintf(stderr, "kernel_launch: hipFuncSetAttribute failed\n"); }
        if (hipOccupancyMaxActiveBlocksPerMultiprocessor(&per_cu, (const void*)fwd_megakernel, 512, LDS_BYTES) != hipSuccess || per_cu < 1) { fprintf(stderr, "kernel_launch: occupancy query gave %d\n", per_cu); per_cu = 1; }
        (void)hipGetLastError();
        grid = cus * per_cu; if (grid > 256) grid = 256; if (grid < 1) grid = 1;
        if (ws_size < WS_END) fprintf(stderr, "kernel_launch: workspace too small: %zu < %zu\n", ws_size, (size_t)WS_END);
    }
    Params p{};
    p.x = (const float*)d_in[0]; p.c = (const float*)d_in[1]; p.ctx = (const float*)d_in[2]; p.c_ctx = (const float*)d_in[3]; p.norm_w = (const float*)d_in[4];
    p.w_ada = (const float*)d_in[5]; p.b_ada = (const float*)d_in[6]; p.w_in = (const float*)d_in[7]; p.lb_logits = (const float*)d_in[8]; p.onorm_w = (const float*)d_in[9];
    p.conv_w = (const float*)d_in[10]; p.w_out = (const float*)d_in[11]; p.fnorm_w = (const float*)d_in[12];
    p.out = (float*)d_out; p.ws = (unsigned char*)d_ws;
#ifndef N_LAUNCH
#define N_LAUNCH 1
#endif
    if (N_LAUNCH == 1) {
        p.ph_lo = 0; p.ph_hi = 7;
        void* args[] = {&p};
        hipError_t e = hipLaunchCooperativeKernel((const void*)fwd_megakernel, dim3(grid), dim3(512), args, LDS_BYTES, stream);
        if (e != hipSuccess) fprintf(stderr, "cooperative launch failed: %s (grid %d)\n", hipGetErrorString(e), grid);
    } else {
        for (int k = 0; k < 7; ++k) { p.ph_lo = k; p.ph_hi = k + 1; hipLaunchKernelGGL(fwd_megakernel, dim3(grid), dim3(512), LDS_BYTES, stream, p); }
    }
}
```

```cpp
#include <hip/hip_runtime.h>
#include <hip/hip_cooperative_groups.h>
#include <cstdio>
#include <cstdint>
namespace cg = cooperative_groups;
namespace pg8 {
#define PG8_LAS __attribute__((address_space(3)))
typedef unsigned short bf16_t;
typedef short bf16x8 __attribute__((ext_vector_type(8)));
typedef float f32x4 __attribute__((ext_vector_type(4)));
typedef unsigned u32x4 __attribute__((ext_vector_type(4)));
constexpr int BM = 256, BK = 64, HALF = 128, HTB = HALF * BK * 2  , STAGE_BYTES = 8 * HTB, NXCD = 8, WGM = 8;

__host__ __device__ __forceinline__ int lds_byte(int r, int c) { const int st = (r >> 4) * 2 + (c >> 5), rr = r & 15, cc = c & 31, ob = rr * 64 + cc * 2; return st * 1024 + (ob ^ (((ob >> 9) & 1) << 5)); }
__host__ __device__ __forceinline__ void stage_rc(int b, int& R, int& C) { const int st = b / 1024, sb = b % 1024, swz = sb ^ (((sb >> 9) & 1) << 5); R = (st >> 1) * 16 + swz / 64; C = (st & 1) * 32 + (swz % 64) / 2; }
__host__ __device__ __forceinline__ int perm32(int rho) { const int n = rho >> 4, i = rho & 15; return 8 * (i >> 2) + 4 * n + (i & 3); }

struct Unit { int pm, pn; };
struct Gemm { const bf16_t* A; const bf16_t* Bt; int M, N, K; };

struct StaticOrder {
    int nM, nN, nwg, G, c;
    __host__ __device__ void init(int M, int N, int G_, int c_) { nM = M / BM; nN = N / BM; nwg = nM * nN; G = G_; c = c_; }
    __host__ __device__ bool next(int i, Unit& u) const {
        const long L = (long)i * G + c; if (L >= nwg) return false;
        int wgid = (int)L; { const int q = nwg / NXCD, r = nwg % NXCD, xcd = wgid % NXCD, off = wgid / NXCD; wgid = (xcd < r ? xcd * (q + 1) : r * (q + 1) + (xcd - r) * q) + off; }
        const int nig = WGM * nN, gid = wgid / nig, fm = gid * WGM, gsz = (nM - fm) < WGM ? (nM - fm) : WGM;
        u.pm = fm + ((wgid % nig) % gsz); u.pn = (wgid % nig) / gsz; return true;
    }
    __device__ __forceinline__ void a_ready(const Unit&) const {}
    __device__ __forceinline__ void done(const Unit&) const {}
};

__device__ __forceinline__ unsigned cvt_pk_bf16(float lo, float hi) { unsigned r; asm volatile("v_cvt_pk_bf16_f32 %0, %1, %2" : "=v"(r) : "v"(lo), "v"(hi)); return r; }
template <class Epi, class Sched, bool ALIGN_EPI = false, bool SP2 = false>
__device__ __forceinline__ void gemm_phase(PG8_LAS unsigned char* lds, const Gemm g, const Sched& S, const Epi& E) {
    const int tid = threadIdx.x, wid = __builtin_amdgcn_readfirstlane(tid >> 6), lane = tid & 63, wr = wid >> 2, wc = wid & 3, fr = lane & 15, fq = lane >> 4;
    const int K = g.K, nt = K / BK;
    unsigned voffA[2], voffB[2];
#pragma unroll
    for (int i = 0; i < 2; ++i) { int R, C; stage_rc(tid * 16 + i * 8192, R, C); const int Rb = Epi::PERM ? ((R & ~31) + perm32(R & 31)) : R;
        voffA[i] = (unsigned)(R * K + C) * 2u; voffB[i] = (unsigned)(Rb * K + C) * 2u; }
    const size_t kstep = (size_t)(BK * 2);
    const size_t hstep = (size_t)HALF * K * 2;
    const size_t tstep = 2 * hstep;
    const unsigned ldsw = (unsigned)wid * 1024u;
    const int aoff = lds_byte(wr * 64 + fr, fq * 8), boff = lds_byte(wc * 32 + fr, fq * 8);
#define PG8_SA(b, h) (((b) * 2 + (h)) * HTB)
#define PG8_SB(b, h) ((4 + (b) * 2 + (h)) * HTB)
#define PG8_STAGE(bufoff, gbase, voff) do { _Pragma("unroll") for (int _i = 0; _i < 2; ++_i) \
        __builtin_amdgcn_global_load_lds((const unsigned*)((const char*)(gbase) + (voff)[_i]), (PG8_LAS unsigned*)(lds + (bufoff) + ldsw + _i * 8192), 16, 0, 0); } while (0)
#define PG8_LDA(dst, b, h) do { _Pragma("unroll") for (int m = 0; m < 4; ++m) _Pragma("unroll") for (int k = 0; k < 2; ++k) dst[m][k] = *(const PG8_LAS bf16x8*)(lds + PG8_SA(b, h) + aoff + m * 2048 + k * 1024); } while (0)
#define PG8_LDB(dst, b, h) do { _Pragma("unroll") for (int n = 0; n < 2; ++n) _Pragma("unroll") for (int k = 0; k < 2; ++k) dst[n][k] = *(const PG8_LAS bf16x8*)(lds + PG8_SB(b, h) + boff + n * 2048 + k * 1024); } while (0)
#define PG8_MMA(ai, bj, At, Bt) do { __builtin_amdgcn_s_setprio(1); _Pragma("unroll") for (int m = 0; m < 4; ++m) _Pragma("unroll") for (int n = 0; n < 2; ++n) _Pragma("unroll") for (int k = 0; k < 2; ++k) \
        acc[ai][bj][m][n] = __builtin_amdgcn_mfma_f32_16x16x32_bf16(Bt[n][k], At[m][k], acc[ai][bj][m][n], 0, 0, 0); __builtin_amdgcn_s_setprio(0); } while (0)
#define PG8_WAIT_V(n) asm volatile("s_waitcnt vmcnt(" #n ")" ::: "memory")
#define PG8_WAIT_L(n) asm volatile("s_waitcnt lgkmcnt(" #n ")" ::: "memory")
#define PG8_BAR __builtin_amdgcn_s_barrier()
#define PG8_SCHED __builtin_amdgcn_sched_barrier(0)
    Unit cur, nxt; int ui = 0;
    if (!S.next(0, cur)) return;
    f32x4 acc[2][2][4][2];
#pragma unroll
    for (int a = 0; a < 2; ++a)
#pragma unroll
        for (int b = 0; b < 2; ++b)
#pragma unroll
            for (int m = 0; m < 4; ++m)
#pragma unroll
                for (int n = 0; n < 2; ++n) acc[a][b][m][n] = (f32x4){0.f, 0.f, 0.f, 0.f};
    bf16x8 At[4][2], B0[2][2], B1[2][2];
    const char* cA = (const char*)g.A + (size_t)cur.pm * tstep; const char* cB = (const char*)g.Bt + (size_t)cur.pn * tstep;
    S.a_ready(cur);
    if constexpr (SP2) {
        PG8_STAGE(PG8_SB(0, 0), cB, voffB); PG8_STAGE(PG8_SB(0, 1), cB + hstep, voffB); PG8_STAGE(PG8_SA(0, 0), cA, voffA); PG8_STAGE(PG8_SA(0, 1), cA + hstep, voffA);
        if (wr == 1) PG8_BAR;
        PG8_WAIT_V(2); PG8_BAR;
        PG8_STAGE(PG8_SB(1, 0), cB + kstep, voffB); PG8_STAGE(PG8_SA(1, 0), cA + kstep, voffA); PG8_STAGE(PG8_SB(1, 1), cB + hstep + kstep, voffB);
        PG8_WAIT_V(6); PG8_BAR;
    } else {
        PG8_STAGE(PG8_SB(0, 0), cB, voffB); PG8_STAGE(PG8_SA(0, 0), cA, voffA); PG8_STAGE(PG8_SB(0, 1), cB + hstep, voffB); PG8_STAGE(PG8_SA(0, 1), cA + hstep, voffA);
        if (wr == 1) PG8_BAR;
        PG8_WAIT_V(4); PG8_BAR;
        PG8_STAGE(PG8_SB(1, 0), cB + kstep, voffB); PG8_STAGE(PG8_SA(1, 0), cA + kstep, voffA); PG8_STAGE(PG8_SB(1, 1), cB + hstep + kstep, voffB);
        PG8_WAIT_V(6); PG8_BAR;
    }
    for (;;) {
        const bool has_next = S.next(ui + 1, nxt);
        const char* nA = has_next ? (const char*)g.A + (size_t)nxt.pm * tstep : cA; const char* nB = has_next ? (const char*)g.Bt + (size_t)nxt.pn * tstep : cB;
        for (int t = 0; t < nt; t += 2) {
            const bool last = (t == nt - 2);
            const char* a1 = cA + (size_t)(t + 1) * kstep;
            const char* a2 = last ? nA : cA + (size_t)(t + 2) * kstep; const char* b2 = last ? nB : cB + (size_t)(t + 2) * kstep;
            const char* a3 = a2 + kstep; const char* b3 = b2 + kstep;
            if (last && has_next) S.a_ready(nxt);
            if constexpr (SP2) {
            PG8_LDB(B0, 0, 0); PG8_LDB(B1, 0, 1); PG8_SCHED; PG8_LDA(At, 0, 0); PG8_STAGE(PG8_SA(1, 1), a1 + hstep, voffA);
            PG8_WAIT_V(8); PG8_WAIT_L(0); PG8_BAR; PG8_MMA(0, 0, At, B0); PG8_MMA(0, 1, At, B1); PG8_BAR; PG8_SCHED;
            PG8_LDA(At, 0, 1); PG8_STAGE(PG8_SB(0, 0), b2, voffB); PG8_STAGE(PG8_SB(0, 1), b2 + hstep, voffB); PG8_STAGE(PG8_SA(0, 0), a2, voffA);
            PG8_WAIT_V(8); PG8_WAIT_L(0); PG8_BAR; PG8_MMA(1, 0, At, B0); PG8_MMA(1, 1, At, B1); PG8_BAR; PG8_SCHED;
            PG8_LDB(B0, 1, 0); PG8_LDB(B1, 1, 1); PG8_SCHED; PG8_LDA(At, 1, 0); PG8_STAGE(PG8_SA(0, 1), a2 + hstep, voffA);
            PG8_WAIT_V(8); PG8_WAIT_L(0); PG8_BAR; PG8_MMA(0, 0, At, B0); PG8_MMA(0, 1, At, B1); PG8_BAR; PG8_SCHED;
            PG8_LDA(At, 1, 1); PG8_STAGE(PG8_SB(1, 0), b3, voffB); PG8_STAGE(PG8_SB(1, 1), b3 + hstep, voffB); PG8_STAGE(PG8_SA(1, 0), a3, voffA);
            PG8_WAIT_V(8); PG8_WAIT_L(0); PG8_BAR; PG8_MMA(1, 0, At, B0); PG8_MMA(1, 1, At, B1); PG8_BAR; PG8_SCHED;
            } else {
            PG8_LDB(B0, 0, 0); PG8_SCHED; PG8_LDA(At, 0, 0); PG8_STAGE(PG8_SA(1, 1), a1 + hstep, voffA);
            PG8_WAIT_L(8); PG8_BAR; PG8_WAIT_L(0); PG8_MMA(0, 0, At, B0); PG8_BAR; PG8_SCHED;
            PG8_LDB(B1, 0, 1); PG8_STAGE(PG8_SB(0, 0), b2, voffB);
            PG8_BAR; PG8_WAIT_L(0); PG8_MMA(0, 1, At, B1); PG8_BAR;
            PG8_LDA(At, 0, 1); PG8_STAGE(PG8_SA(0, 0), a2, voffA);
            PG8_BAR; PG8_WAIT_L(0); PG8_MMA(1, 0, At, B0); PG8_BAR; PG8_SCHED;
            PG8_STAGE(PG8_SB(0, 1), b2 + hstep, voffB);
            PG8_WAIT_V(6); PG8_BAR; PG8_MMA(1, 1, At, B1); PG8_BAR;
            PG8_LDB(B0, 1, 0); PG8_SCHED; PG8_LDA(At, 1, 0); PG8_STAGE(PG8_SA(0, 1), a2 + hstep, voffA);
            PG8_WAIT_L(8); PG8_BAR; PG8_WAIT_L(0); PG8_MMA(0, 0, At, B0); PG8_BAR; PG8_SCHED;
            PG8_LDB(B1, 1, 1); PG8_STAGE(PG8_SB(1, 0), b3, voffB);
            PG8_BAR; PG8_WAIT_L(0); PG8_MMA(0, 1, At, B1); PG8_BAR;
            PG8_LDA(At, 1, 1); PG8_STAGE(PG8_SA(1, 0), a3, voffA);
            PG8_BAR; PG8_WAIT_L(0); PG8_MMA(1, 0, At, B0); PG8_BAR; PG8_SCHED;
            PG8_STAGE(PG8_SB(1, 1), b3 + hstep, voffB);
            PG8_WAIT_V(6); PG8_BAR; PG8_MMA(1, 1, At, B1); PG8_BAR;
            }
        }
        if constexpr (ALIGN_EPI) { if (wr == 0) PG8_BAR; }
        if constexpr (!Epi::AFTER_DRAIN) { E(acc, cur, wr, wc, fr, fq); S.done(cur); }
        if (!has_next) break;
#pragma unroll
        for (int a = 0; a < 2; ++a)
#pragma unroll
            for (int b = 0; b < 2; ++b)
#pragma unroll
                for (int m = 0; m < 4; ++m)
#pragma unroll
                    for (int n = 0; n < 2; ++n) acc[a][b][m][n] = (f32x4){0.f, 0.f, 0.f, 0.f};
        cur = nxt; cA = nA; cB = nB; ++ui;
        if constexpr (ALIGN_EPI) { if (wr == 1) PG8_BAR; }
    }
    PG8_WAIT_V(0);
    if constexpr (!ALIGN_EPI) { if (wr == 0) PG8_BAR; }
    PG8_BAR;
    if constexpr (Epi::AFTER_DRAIN) { E.fused(acc, cur, wr, wc, fr, fq, lds, wid, lane); S.done(cur); }
#undef PG8_SA
#undef PG8_SB
#undef PG8_STAGE
#undef PG8_LDA
#undef PG8_LDB
#undef PG8_MMA
#undef PG8_WAIT_V
#undef PG8_WAIT_L
#undef PG8_BAR
#undef PG8_SCHED
}
}

#define LAS __attribute__((address_space(3)))
typedef unsigned short bf16;
typedef unsigned v4u __attribute__((ext_vector_type(4)));
typedef unsigned v2u __attribute__((ext_vector_type(2)));
typedef float f32x4 __attribute__((ext_vector_type(4)));
typedef short bf16x8 __attribute__((ext_vector_type(8)));

constexpr int DM = 1024, NB = 4, SEQ = 4096, CTXL = 256, MROWS = NB * SEQ, MCROWS = NB * CTXL, NHEAD = 8;
constexpr int N1 = 9216, MIXW = 2048;
constexpr float EPSN = 1e-6f;
constexpr size_t MiB = 1u << 20;
constexpr size_t WS_MOD = 0;
constexpr size_t WS_LB = 64 * 1024;
constexpr size_t WS_BT2 = 1 * MiB;
constexpr size_t WS_DF = 5 * MiB, WS_DB = 6 * MiB;
constexpr size_t WS_CDF = 7 * MiB, WS_CDB = 7 * MiB + 512 * 1024;
constexpr size_t WS_CKEF = 8 * MiB, WS_CKEB = 10 * MiB, WS_CV = 12 * MiB;
constexpr size_t WS_H = 14 * MiB;
constexpr size_t WS_OF = 14 * MiB;
constexpr size_t WS_HC = 46 * MiB;
constexpr size_t WS_BT1 = 48 * MiB;
constexpr size_t WS_OB = 46 * MiB;
constexpr size_t WS_YCAT = 78 * MiB;
constexpr size_t WS_QEB = 142 * MiB, WS_KEB = 174 * MiB, WS_V = 206 * MiB;
constexpr size_t WS_END = 238 * MiB;
constexpr int LDS_BYTES = 147456;

struct Params {
    const float *x, *c, *ctx, *c_ctx, *norm_w, *w_ada, *b_ada, *w_in, *lb_logits, *onorm_w, *conv_w, *w_out, *fnorm_w;
    float* out; unsigned char* ws; int ph_lo, ph_hi;
};

typedef float f32x2v __attribute__((ext_vector_type(2)));
typedef __bf16 bf16x2v __attribute__((ext_vector_type(2)));
__device__ __forceinline__ unsigned cvtpk(float lo, float hi) { const f32x2v v = {lo, hi}; return __builtin_bit_cast(unsigned, __builtin_convertvector(v, bf16x2v)); }
__device__ __forceinline__ float bf_lo(unsigned u) { return __builtin_bit_cast(float, u << 16); }
__device__ __forceinline__ float bf_hi(unsigned u) { return __builtin_bit_cast(float, u & 0xffff0000u); }
__device__ __forceinline__ float sigm(float z) { return __builtin_amdgcn_rcpf(1.0f + __builtin_amdgcn_exp2f(-1.44269504f * z)); }
__device__ __forceinline__ float wave_sum(float v) {
#pragma unroll
    for (int o = 1; o < 64; o <<= 1) v += __shfl_xor(v, o);
    return v;
}
__device__ __forceinline__ float rowscan_fwd(float x, int fr, int lane) {
#pragma unroll
    for (int d = 1; d < 16; d <<= 1) { const float y = __shfl(x, (lane - d) & 63); x = (fr >= d) ? x * y : x; }
    return x;
}
__device__ __forceinline__ float rowscan_bwd(float x, int fr, int lane) {
#pragma unroll
    for (int d = 1; d < 16; d <<= 1) { const float y = __shfl(x, (lane + d) & 63); x = (fr + d < 16) ? x * y : x; }
    return x;
}

__device__ __forceinline__ int srccol1(int np) {
    const int pn = np >> 8, c = np & 255, bj = c >> 7, wc = (c >> 5) & 3, n = (c >> 4) & 1, fq = (c >> 2) & 3, j = c & 3;
    if (pn < 16) return (bj * 2 + n) * 1024 + pn * 64 + wc * 16 + fq * 4 + j;
    if (pn < 20) return 4096 + (pn - 16) * 256 + bj * 128 + wc * 32 + fq * 8 + n * 4 + j;
    return 5120 + (bj * 2 + n) * 1024 + (pn - 20) * 64 + wc * 16 + fq * 4 + j;
}

struct Order1 {
    pg8::StaticOrder so; int G, c;
    __device__ void init(int G_, int c_) { G = G_; c = c_; so.init(MROWS, N1, 1, 0); }
    __device__ bool next(int i, pg8::Unit& u) const {
        const long L = (long)i * G + c; if (L >= 64 + 2304) return false;
        if (L < 64) { u.pm = 64 + (int)(L >> 4); u.pn = (int)(L & 15); return true; }
        pg8::StaticOrder t = so; t.G = 1; t.c = (int)(L - 64); return t.next(0, u);
    }
    __device__ __forceinline__ void a_ready(const pg8::Unit&) const {}
    __device__ __forceinline__ void done(const pg8::Unit&) const {}
};

struct Epi1 {
    static constexpr bool PERM = false, AFTER_DRAIN = false;
    const float* LB; const float* conv_w;
    bf16 *QEF, *KEF, *QEB, *KEB, *V, *CKEF, *CKEB, *CV, *YCAT; float *DF, *DB, *CDF, *CDB;
    __device__ __forceinline__ void operator()(const f32x4 (&acc)[2][2][4][2], const pg8::Unit& u, int wr, int wc, int fr, int fq) const {
        const int lane = fq * 16 + fr;
        if (u.pn < 16) {
            const bool ctx = u.pm >= 64;
            const int TT = ctx ? CTXL : SEQ, NC = TT >> 6;
            const int row_base = ctx ? (u.pm - 64) * 256 : u.pm * 256;
            const int h = u.pn >> 1, kk0 = (u.pn & 1) * 64 + wc * 16 + fq * 4, ch0 = h * 128 + kk0;
            const f32x4 lbf = *(const f32x4*)(LB + ch0), lbb = *(const f32x4*)(LB + 1024 + ch0);
            bf16* pkf = ctx ? CKEF : KEF; bf16* pkb = ctx ? CKEB : KEB; bf16* pv = ctx ? CV : V;
            float* pdf = ctx ? CDF : DF; float* pdb = ctx ? CDB : DB;
#pragma unroll
            for (int ai = 0; ai < 2; ++ai) {
                const int rb = row_base + ai * 128 + wr * 64;
                const int b = rb / TT, T0 = rb - b * TT, chunk = T0 >> 6;
                const size_t tok0 = (size_t)(b * 8 + h) * TT + T0;
                const size_t doff = ((size_t)(b * 8 + h) * NC + chunk) * 128 + kk0;
                float qf[4][4], kf[4][4], qb[4][4], kb[4][4];
#pragma unroll
                for (int j = 0; j < 4; ++j) {
                    float f[4], g[4];
#pragma unroll
                    for (int m = 0; m < 4; ++m) {
                        f[m] = (1.0f - lbf[j]) * (1.0f - sigm(acc[ai][1][m][0][j]));
                        g[m] = (1.0f - lbb[j]) * (1.0f - sigm(acc[ai][1][m][1][j]));
                    }
                    float carry = 1.0f;
#pragma unroll
                    for (int m = 0; m < 4; ++m) {
                        const float sc = rowscan_fwd(1.0f - f[m], fr, lane); const float tot = __shfl(sc, lane | 15);
                        const float P = fmaxf(sc * carry, 1e-30f); carry *= tot;
                        const float q = acc[ai][0][m][0][j]; qf[m][j] = q * P; kf[m][j] = f[m] * __builtin_amdgcn_rcpf(P);
                    }
                    if (fr == 0) pdf[doff + j] = carry;
                    carry = 1.0f;
#pragma unroll
                    for (int m = 3; m >= 0; --m) {
                        const float sc = rowscan_bwd(1.0f - g[m], fr, lane); const float tot = __shfl(sc, lane & 48);
                        const float P = fmaxf(sc * carry, 1e-30f); carry *= tot;
                        const float q = acc[ai][0][m][0][j]; qb[m][j] = q * P; kb[m][j] = g[m] * __builtin_amdgcn_rcpf(P);
                    }
                    if (fr == 0) pdb[doff + j] = carry;
                }
#pragma unroll
                for (int m = 0; m < 4; ++m) {
                    const size_t off = (tok0 + 16 * m + fr) * 128 + kk0;
                    v2u w;
                    if (!ctx) { w.x = cvtpk(qf[m][0], qf[m][1]); w.y = cvtpk(qf[m][2], qf[m][3]); *(v2u*)(QEF + off) = w;
                                w.x = cvtpk(qb[m][0], qb[m][1]); w.y = cvtpk(qb[m][2], qb[m][3]); *(v2u*)(QEB + off) = w; }
                    w.x = cvtpk(kf[m][0], kf[m][1]); w.y = cvtpk(kf[m][2], kf[m][3]); *(v2u*)(pkf + off) = w;
                    w.x = cvtpk(kb[m][0], kb[m][1]); w.y = cvtpk(kb[m][2], kb[m][3]); *(v2u*)(pkb + off) = w;
                    const f32x4 vv = acc[ai][0][m][1];
                    w.x = cvtpk(vv[0], vv[1]); w.y = cvtpk(vv[2], vv[3]); *(v2u*)(pv + off) = w;
                }
            }
        } else if (u.pn < 20) {
            const int col0 = (u.pn - 16) * 256 + wc * 32 + fq * 8;
#pragma unroll
            for (int ai = 0; ai < 2; ++ai)
#pragma unroll
                for (int m = 0; m < 4; ++m) {
                    const size_t r = (size_t)u.pm * 256 + ai * 128 + wr * 64 + 16 * m + fr;
#pragma unroll
                    for (int bj = 0; bj < 2; ++bj) {
                        const f32x4 a0 = acc[ai][bj][m][0], a1 = acc[ai][bj][m][1];
                        v4u w;
                        w.x = cvtpk(a0[0] * sigm(a0[0]), a0[1] * sigm(a0[1])); w.y = cvtpk(a0[2] * sigm(a0[2]), a0[3] * sigm(a0[3]));
                        w.z = cvtpk(a1[0] * sigm(a1[0]), a1[1] * sigm(a1[1])); w.w = cvtpk(a1[2] * sigm(a1[2]), a1[3] * sigm(a1[3]));
                        *(v4u*)(YCAT + r * MIXW + col0 + bj * 128) = w;
                    }
                }
        } else {
            const int ch0 = (u.pn - 20) * 64 + wc * 16 + fq * 4;
            const f32x4 cw0 = *(const f32x4*)(conv_w + ch0), cw1 = *(const f32x4*)(conv_w + 1024 + ch0), cw2 = *(const f32x4*)(conv_w + 2048 + ch0);
            const int src_prev = (fr == 0) ? lane + 15 : lane - 1, src_next = (fr == 15) ? lane - 15 : lane + 1;
#pragma unroll
            for (int ai = 0; ai < 2; ++ai) {
                float y[4][4];
#pragma unroll
                for (int j = 0; j < 4; ++j) {
                    float uu[4];
#pragma unroll
                    for (int m = 0; m < 4; ++m) uu[m] = acc[ai][1][m][0][j] * acc[ai][0][m][0][j];
#pragma unroll
                    for (int m = 0; m < 4; ++m) {
                        const float um1 = (m > 0) ? uu[m > 0 ? m - 1 : 0] : 0.0f, up1 = (m < 3) ? uu[m < 3 ? m + 1 : 3] : 0.0f;
                        const float prev = __shfl((fr == 15) ? um1 : uu[m], src_prev);
                        const float next = __shfl((fr == 0) ? up1 : uu[m], src_next);
                        const float cv = cw0[j] * prev + cw1[j] * uu[m] + cw2[j] * next;
                        const float gt = acc[ai][1][m][1][j];
                        y[m][j] = acc[ai][0][m][1][j] * cv * (gt * sigm(gt));
                    }
                }
#pragma unroll
                for (int m = 0; m < 4; ++m) {
                    const size_t r = (size_t)u.pm * 256 + ai * 128 + wr * 64 + 16 * m + fr;
                    v2u w; w.x = cvtpk(y[m][0], y[m][1]); w.y = cvtpk(y[m][2], y[m][3]);
                    *(v2u*)(YCAT + r * MIXW + 1024 + ch0) = w;
                }
            }
        }
    }
};

struct Epi2 {
    static constexpr bool PERM = false, AFTER_DRAIN = false;
    const float* x; const float* MOD; float* out;
    __device__ __forceinline__ void operator()(const f32x4 (&acc)[2][2][4][2], const pg8::Unit& u, int wr, int wc, int fr, int fq) const {
        const int col0 = u.pn * 256 + wc * 32 + 4 * fq; const int b = (u.pm * 256) >> 12;
        f32x4 gv[2][2];
#pragma unroll
        for (int bj = 0; bj < 2; ++bj)
#pragma unroll
            for (int n = 0; n < 2; ++n) gv[bj][n] = *(const f32x4*)(MOD + b * 3072 + 2048 + col0 + bj * 128 + n * 16);
#pragma unroll
        for (int ai = 0; ai < 2; ++ai)
#pragma unroll
            for (int m = 0; m < 4; ++m) {
                const size_t off = ((size_t)u.pm * 256 + ai * 128 + wr * 64 + 16 * m + fr) * DM + col0;
#pragma unroll
                for (int bj = 0; bj < 2; ++bj)
#pragma unroll
                    for (int n = 0; n < 2; ++n) {
                        const f32x4 xv = *(const f32x4*)(x + off + bj * 128 + n * 16);
                        *(f32x4*)(out + off + bj * 128 + n * 16) = xv + gv[bj][n] * acc[ai][bj][m][n];
                    }
            }
    }
};

template <bool MAP>
__device__ __forceinline__ void p0_transpose_item(const float* W, int K, int N, bf16* WT, LAS float* scr, int item, int lane, int nblk) {
    const int kb = item / nblk, nb = item % nblk, k0 = 64 * kb, n0 = 32 * nb;
    const int sc = MAP ? srccol1(n0 + (lane & 31)) : n0 + (lane & 31);
#pragma unroll 8
    for (int i = 0; i < 32; ++i) { const int kk = 2 * i + (lane >> 5); scr[kk * 33 + (lane & 31)] = W[(size_t)(k0 + kk) * N + sc]; }
    asm volatile("s_waitcnt lgkmcnt(0)" ::: "memory");
    const int c = lane & 7;
#pragma unroll
    for (int j = 0; j < 4; ++j) { const int n = (lane >> 3) + 8 * j; const LAS float* s = scr + (8 * c) * 33 + n;
        v4u o; o.x = cvtpk(s[0 * 33], s[1 * 33]); o.y = cvtpk(s[2 * 33], s[3 * 33]); o.z = cvtpk(s[4 * 33], s[5 * 33]); o.w = cvtpk(s[6 * 33], s[7 * 33]);
        *(v4u*)(WT + (size_t)(n0 + n) * K + k0 + 8 * c) = o; }
    asm volatile("s_waitcnt lgkmcnt(0)" ::: "memory");
}

__device__ __forceinline__ void p0_gemv(const Params& P, LAS unsigned char* lds, int nb, int tid, int wave, int lane) {
    LAS float* sil = (LAS float*)lds;
    LAS float* red = sil + 5120;
    for (int i = tid; i < 5120; i += 512) { const int v = i >> 10, k = i & 1023; const float cc = (v < 4) ? P.c[v * 1024 + k] : P.c_ctx[k]; sil[i] = cc * sigm(cc); }
    __syncthreads();
    const int kh = lane >> 5, col = lane & 31, n0 = nb * 32;
    float a0 = 0.f, a1 = 0.f, a2 = 0.f, a3 = 0.f, a4 = 0.f;
#pragma unroll 8
    for (int i = 0; i < 64; ++i) {
        const int k = 128 * wave + 2 * i + kh; const float wv = P.w_ada[(size_t)k * 3072 + n0 + col];
        a0 += sil[k] * wv; a1 += sil[1024 + k] * wv; a2 += sil[2048 + k] * wv; a3 += sil[3072 + k] * wv; a4 += sil[4096 + k] * wv;
    }
    a0 += __shfl_xor(a0, 32); a1 += __shfl_xor(a1, 32); a2 += __shfl_xor(a2, 32); a3 += __shfl_xor(a3, 32); a4 += __shfl_xor(a4, 32);
    if (lane < 32) { red[(wave * 5 + 0) * 32 + col] = a0; red[(wave * 5 + 1) * 32 + col] = a1; red[(wave * 5 + 2) * 32 + col] = a2; red[(wave * 5 + 3) * 32 + col] = a3; red[(wave * 5 + 4) * 32 + col] = a4; }
    __syncthreads();
    if (tid < 160) { const int v = tid >> 5, cl = tid & 31; float s = P.b_ada[n0 + cl];
#pragma unroll
        for (int w = 0; w < 8; ++w) s += red[(w * 5 + v) * 32 + cl];
        ((float*)(P.ws + WS_MOD))[v * 3072 + n0 + cl] = s; }
    __syncthreads();
}

constexpr int SC_QE = 0, SC_KE = 17408, SC_KET = 34816, SC_VT = 53248, SC_DD = 57856, SC_BUF = 58368;
constexpr int SROW = 272, TROW = 144;

struct ScanRegs { v4u q0, q1, k0, k1, vv; float d; };

__device__ __forceinline__ void scan_load(ScanRegs& R, const bf16* qe, const bf16* ke, const bf16* v, const float* D, bool has_q, int tid, int vs) {
    const int row = tid & 63, kc = tid >> 6;
    if (has_q) { R.q0 = *(const v4u*)(qe + row * 128 + kc * 8); R.q1 = *(const v4u*)(qe + row * 128 + (kc + 8) * 8); }
    R.k0 = *(const v4u*)(ke + row * 128 + kc * 8); R.k1 = *(const v4u*)(ke + row * 128 + (kc + 8) * 8);
    if (tid < 256) R.vv = *(const v4u*)(v + (tid & 63) * 128 + vs * 32 + (tid >> 6) * 8);
    if (tid < 128) R.d = D[tid];
}
__device__ __forceinline__ void st16x8_T(LAS unsigned char* base, int rowstride, int r0, int col, v4u w) {
    LAS unsigned short* p = (LAS unsigned short*)(base + r0 * rowstride + col * 2);
    const int rs = rowstride >> 1;
    p[0 * rs] = (unsigned short)(w.x & 0xffff); p[1 * rs] = (unsigned short)(w.x >> 16);
    p[2 * rs] = (unsigned short)(w.y & 0xffff); p[3 * rs] = (unsigned short)(w.y >> 16);
    p[4 * rs] = (unsigned short)(w.z & 0xffff); p[5 * rs] = (unsigned short)(w.z >> 16);
    p[6 * rs] = (unsigned short)(w.w & 0xffff); p[7 * rs] = (unsigned short)(w.w >> 16);
}
__device__ __forceinline__ void scan_store(const ScanRegs& R, LAS unsigned char* buf, bool has_q, int tid) {
    const int row = tid & 63, kc = tid >> 6;
    if (has_q) { *(LAS v4u*)(buf + SC_QE + row * SROW + kc * 16) = R.q0; *(LAS v4u*)(buf + SC_QE + row * SROW + (kc + 8) * 16) = R.q1; }
    *(LAS v4u*)(buf + SC_KE + row * SROW + kc * 16) = R.k0; *(LAS v4u*)(buf + SC_KE + row * SROW + (kc + 8) * 16) = R.k1;
    st16x8_T(buf + SC_KET, TROW, kc * 8, row, R.k0); st16x8_T(buf + SC_KET, TROW, (kc + 8) * 8, row, R.k1);
    if (tid < 256) st16x8_T(buf + SC_VT, TROW, (tid >> 6) * 8, tid & 63, R.vv);
    if (tid < 128) *(LAS float*)(buf + SC_DD + tid * 4) = R.d;
}
__device__ __forceinline__ bf16x8 ld2x64(const LAS unsigned char* p) {
    const v2u a = *(const LAS v2u*)p, b = *(const LAS v2u*)(p + 32);
    v4u w; w.x = a.x; w.y = a.y; w.z = b.x; w.w = b.y; return __builtin_bit_cast(bf16x8, w);
}

__device__ __forceinline__ void scan_phase(const Params& P, LAS unsigned char* lds, int tid, int wave, int lane) {
    const int fr = lane & 15, fq = lane >> 4, tb = wave >> 1, vb = wave & 1;
    unsigned char* ws = P.ws;
    for (int item = blockIdx.x; item < 256; item += gridDim.x) {
        const int xcd = item & 7, idx = item >> 3, seq = xcd * 8 + (idx >> 2), vs = idx & 3, dir = seq & 1, h = (seq >> 1) & 7, b = seq >> 4;
        const int bh = b * 8 + h;
        const bf16* qe_base = (dir ? (const bf16*)(ws + WS_QEB) : (const bf16*)P.out) + (size_t)bh * SEQ * 128;
        const bf16* ke_base = (dir ? (const bf16*)(ws + WS_KEB) : (const bf16*)P.out + (size_t)16 * MiB) + (size_t)bh * SEQ * 128;
        const bf16* v_base = (const bf16*)(ws + WS_V) + (size_t)bh * SEQ * 128;
        const float* d_base = (const float*)(ws + (dir ? WS_DB : WS_DF)) + (size_t)bh * 64 * 128;
        const bf16* cke_base = (const bf16*)(ws + (dir ? WS_CKEB : WS_CKEF)) + (size_t)bh * CTXL * 128;
        const bf16* cv_base = (const bf16*)(ws + WS_CV) + (size_t)bh * CTXL * 128;
        const float* cd_base = (const float*)(ws + (dir ? WS_CDB : WS_CDF)) + (size_t)bh * 4 * 128;
        bf16* o_base = (bf16*)(ws + (dir ? WS_OB : WS_OF)) + (size_t)b * SEQ * DM + h * 128 + vs * 32 + vb * 16 + fq * 4;
        f32x4 S[8];
#pragma unroll
        for (int kb = 0; kb < 8; ++kb) S[kb] = (f32x4){0.f, 0.f, 0.f, 0.f};
        constexpr int NSTEP = 68;
        ScanRegs R;
#define SCAN_LOAD(step) do { const int _s = (step); if (_s < 4) { const int cc = dir ? 3 - _s : _s; \
            scan_load(R, cke_base, cke_base + (size_t)cc * 64 * 128, cv_base + (size_t)cc * 64 * 128, cd_base + cc * 128, false, tid, vs); } \
          else { const int lc = dir ? 63 - (_s - 4) : (_s - 4); \
            scan_load(R, qe_base + (size_t)lc * 64 * 128, ke_base + (size_t)lc * 64 * 128, v_base + (size_t)lc * 64 * 128, d_base + lc * 128, true, tid, vs); } } while (0)
        SCAN_LOAD(0);
        scan_store(R, lds, false, tid);
        SCAN_LOAD(1);
        __syncthreads();
        for (int step = 0; step < NSTEP; ++step) {
            LAS unsigned char* buf = lds + (step & 1) * SC_BUF;
            LAS unsigned char* nbuf = lds + ((step + 1) & 1) * SC_BUF;
            if (step + 1 < NSTEP) scan_store(R, nbuf, step + 1 >= 4, tid);
            if (step + 2 < NSTEP) SCAN_LOAD(step + 2);
            const bool lat = step >= 4;
            if (lat) {
                const int lc = dir ? 63 - (step - 4) : (step - 4);
                bf16x8 qfr[4];
#pragma unroll
                for (int kk = 0; kk < 4; ++kk) qfr[kk] = *(const LAS bf16x8*)(buf + SC_QE + (tb * 16 + fr) * SROW + (kk * 32 + fq * 8) * 2);
                f32x4 At[4];
#pragma unroll
                for (int sb = 0; sb < 4; ++sb) {
                    At[sb] = (f32x4){0.f, 0.f, 0.f, 0.f};
                    const bool need = dir ? (sb >= tb) : (sb <= tb);
                    if (need) {
#pragma unroll
                        for (int kk = 0; kk < 4; ++kk) {
                            const bf16x8 kfr = *(const LAS bf16x8*)(buf + SC_KE + (sb * 16 + fr) * SROW + (kk * 32 + fq * 8) * 2);
                            At[sb] = __builtin_amdgcn_mfma_f32_16x16x32_bf16(kfr, qfr[kk], At[sb], 0, 0, 0);
                        }
                        if (sb == tb) {
#pragma unroll
                            for (int j = 0; j < 4; ++j) { const bool keep = dir ? (4 * fq + j >= fr) : (4 * fq + j <= fr); At[sb][j] = keep ? At[sb][j] : 0.f; }
                        }
                    }
                }
                f32x4 o = (f32x4){0.f, 0.f, 0.f, 0.f};
#pragma unroll
                for (int p = 0; p < 2; ++p) {
                    const bool need = dir ? (2 * p + 1 >= tb) : (2 * p <= tb);
                    if (need) {
                        v4u w; w.x = cvtpk(At[2 * p][0], At[2 * p][1]); w.y = cvtpk(At[2 * p][2], At[2 * p][3]); w.z = cvtpk(At[2 * p + 1][0], At[2 * p + 1][1]); w.w = cvtpk(At[2 * p + 1][2], At[2 * p + 1][3]);
                        const bf16x8 vfr = ld2x64(buf + SC_VT + (vb * 16 + fr) * TROW + (32 * p + 4 * fq) * 2);
                        o = __builtin_amdgcn_mfma_f32_16x16x32_bf16(vfr, __builtin_bit_cast(bf16x8, w), o, 0, 0, 0);
                    }
                }
#pragma unroll
                for (int kk = 0; kk < 4; ++kk) {
                    v4u w; w.x = cvtpk(S[2 * kk][0], S[2 * kk][1]); w.y = cvtpk(S[2 * kk][2], S[2 * kk][3]); w.z = cvtpk(S[2 * kk + 1][0], S[2 * kk + 1][1]); w.w = cvtpk(S[2 * kk + 1][2], S[2 * kk + 1][3]);
                    const bf16x8 qT = ld2x64(buf + SC_QE + (tb * 16 + fr) * SROW + (32 * kk + 4 * fq) * 2);
                    o = __builtin_amdgcn_mfma_f32_16x16x32_bf16(__builtin_bit_cast(bf16x8, w), qT, o, 0, 0, 0);
                }
                v2u ow; ow.x = cvtpk(o[0], o[1]); ow.y = cvtpk(o[2], o[3]);
                *(v2u*)(o_base + (size_t)(lc * 64 + tb * 16 + fr) * DM) = ow;
            }
            {
                bf16x8 vfr[2];
#pragma unroll
                for (int ss = 0; ss < 2; ++ss) vfr[ss] = *(const LAS bf16x8*)(buf + SC_VT + (vb * 16 + fr) * TROW + (ss * 32 + fq * 8) * 2);
#pragma unroll
                for (int kb = 0; kb < 8; ++kb) {
#pragma unroll
                    for (int ss = 0; ss < 2; ++ss) {
                        const bf16x8 kt = *(const LAS bf16x8*)(buf + SC_KET + (kb * 16 + fr) * TROW + (ss * 32 + fq * 8) * 2);
                        S[kb] = __builtin_amdgcn_mfma_f32_16x16x32_bf16(kt, vfr[ss], S[kb], 0, 0, 0);
                    }
                    const f32x4 dk = *(const LAS f32x4*)(buf + SC_DD + (kb * 16 + fq * 4) * 4);
                    S[kb] = S[kb] * dk;
                }
            }
            __syncthreads();
        }
#undef SCAN_LOAD
    }
}

#define RLX_AGENT __ATOMIC_RELAXED, __HIP_MEMORY_SCOPE_AGENT
constexpr size_t WS_CTL = 128 * 1024;
constexpr int LDS_MISC = 131072 + 64;
#define XB_TMO      128
#define XB_XCNT(j)  (256  + 64 * (j))
#define XB_XSUB(j)  (1280 + 64 * (j))
#define XB_XGEN(j)  (2304 + 64 * (j))
#define XB_TOP      3328
#define XB_TOPGEN   3392
#define XCD_BAR_WORDS 3456
#define XB_SPIN_CAP (1u << 18)

__device__ __forceinline__ unsigned xb_ld(unsigned* p)              { return __hip_atomic_load(p, __ATOMIC_RELAXED, __HIP_MEMORY_SCOPE_AGENT); }
__device__ __forceinline__ unsigned xb_add(unsigned* p, unsigned v) { return __hip_atomic_fetch_add(p, v, __ATOMIC_RELAXED, __HIP_MEMORY_SCOPE_AGENT); }
__device__ __forceinline__ unsigned xb_xcc_id() { return (unsigned)__builtin_amdgcn_s_getreg((3 << 11) | 20) & 0xFu; }
#define XB_SPIN(cond, bar) do { unsigned _sp = 0; while (cond) { __builtin_amdgcn_s_sleep(1); \
    if ((++_sp & 255u) == 0u) { if (xb_ld(&(bar)[XB_TMO])) break; if (_sp > XB_SPIN_CAP) { atomicAdd(&(bar)[XB_TMO], 1u); break; } } } } while (0)

struct XcdBarrier {
    unsigned* bar; unsigned x;
    volatile LAS unsigned* st;
};

__device__ __forceinline__ XcdBarrier xcd_barrier_post(unsigned* bar, volatile LAS unsigned* st) {
    XcdBarrier b; b.bar = bar; b.x = xb_xcc_id(); b.st = st;
    if (threadIdx.x == 0) (void)xb_add(&bar[XB_XCNT(b.x)], 1u);
    return b;
}
__device__ __forceinline__ void xcd_barrier_complete(unsigned* bar, unsigned x, unsigned& nloc, unsigned& nx) {
    const unsigned G = gridDim.x * gridDim.y * gridDim.z;
    unsigned sum, cnt, mine, sp = 0u;
    for (;;) {
        sum = 0u; cnt = 0u; mine = 0u;
#pragma unroll
        for (unsigned j = 0; j < 16; ++j) { const unsigned c = xb_ld(&bar[XB_XCNT(j)]); sum += c; cnt += (c > 0u) ? 1u : 0u; mine = (j == x) ? c : mine; }
        if (sum == G) break;
        __builtin_amdgcn_s_sleep(1);
        if ((++sp & 255u) == 0u) { if (xb_ld(&bar[XB_TMO])) break; if (sp > XB_SPIN_CAP) { atomicAdd(&bar[XB_TMO], 1u); break; } }
    }
    nloc = mine > 0u ? mine : 1u; nx = cnt > 0u ? cnt : 1u;
}

__device__ __forceinline__ void xcd_barrier(const XcdBarrier& b) {
    asm volatile("s_waitcnt vmcnt(0)" ::: "memory");
    __syncthreads();
    if (threadIdx.x == 0) {
        unsigned* bar = b.bar;
        __builtin_amdgcn_s_waitcnt(0);
        unsigned nloc = b.st[0], nx = b.st[1];
        if (nloc == 0u) { xcd_barrier_complete(bar, b.x, nloc, nx); b.st[0] = nloc; b.st[1] = nx; }
        const unsigned old = xb_add(&bar[XB_XSUB(b.x)], 1u);
        const unsigned gen = old / nloc;
        if (old + 1u == (gen + 1u) * nloc) {
            __builtin_amdgcn_fence(__ATOMIC_RELEASE, "agent");
            asm volatile("s_waitcnt vmcnt(0)" ::: "memory");
            const unsigned og = xb_add(&bar[XB_TOP], 1u);
            const unsigned tg = og / nx;
            if (og + 1u == (tg + 1u) * nx) xb_add(&bar[XB_TOPGEN], 1u);
            else XB_SPIN(xb_ld(&bar[XB_TOPGEN]) == tg, bar);
            __builtin_amdgcn_fence(__ATOMIC_ACQUIRE, "agent");
            xb_add(&bar[XB_XGEN(b.x)], 1u);
            asm volatile("s_waitcnt vmcnt(0)" ::: "memory");
        } else {
            XB_SPIN(xb_ld(&bar[XB_XGEN(b.x)]) == gen, bar);
            __builtin_amdgcn_fence(__ATOMIC_ACQUIRE, "agent");
            asm volatile("s_waitcnt vmcnt(0)" ::: "memory");
        }
    }
    __syncthreads();
}

__global__ void __launch_bounds__(512, 2) fwd_megakernel(Params P) {
    extern __shared__ __attribute__((aligned(16))) unsigned char lds_raw[];
    LAS unsigned char* lds = (LAS unsigned char*)lds_raw;
    cg::grid_group grid = cg::this_grid();
#define GRID_SYNC() xcd_barrier(bar)
    const int tid = threadIdx.x, lane = tid & 63, wave = __builtin_amdgcn_readfirstlane(tid >> 6);
    const int G = gridDim.x, gw = blockIdx.x * 8 + wave, NGW = G * 8;
    if (tid < 4) ((LAS unsigned*)(lds + LDS_MISC))[tid] = 0u;
    __syncthreads();
    XcdBarrier bar = xcd_barrier_post((unsigned*)(P.ws + WS_CTL), (volatile LAS unsigned*)(lds + LDS_MISC));
    if (P.ph_hi == 777) grid.sync();
    unsigned char* ws = P.ws;
    float* MOD = (float*)(ws + WS_MOD); float* LB = (float*)(ws + WS_LB);

#define IN(k) (P.ph_lo <= (k) && (k) < P.ph_hi)
#if defined(REP_SYNC)
#define SEAM(k) do { if (IN(k) && IN((k) + 1)) { GRID_SYNC(); GRID_SYNC(); } } while (0)
#else
#define SEAM(k) do { if (IN(k) && IN((k) + 1)) GRID_SYNC(); } while (0)
#endif
    if (IN(0)) {
    if (blockIdx.x == G - 1) {
        for (int i = tid; i < 2048; i += 512) { const int d = i >> 10, ch = i & 1023; const float l0 = P.lb_logits[d * 2048 + ch], l1 = P.lb_logits[d * 2048 + 1024 + ch];
            LB[i] = 1.0f / (1.0f + __expf(l1 - l0)); }
    }
    for (int nb = blockIdx.x; nb < 96; nb += G) p0_gemv(P, lds, nb, tid, wave, lane);
    {
        LAS float* scr = (LAS float*)(lds + wave * 16384);
        constexpr int I1 = (DM / 64) * (N1 / 32), I2 = (MIXW / 64) * (DM / 32);
        for (int it = gw; it < I1 + I2; it += NGW) {
            if (it < I1) p0_transpose_item<true>(P.w_in, DM, N1, (bf16*)(ws + WS_BT1), scr, it, lane, N1 / 32);
            else p0_transpose_item<false>(P.w_out, MIXW, DM, (bf16*)(ws + WS_BT2), scr, it - I1, lane, DM / 32);
        }
    }
    }
    SEAM(0);

    if (IN(1))
    for (int r = gw; r < MROWS + MCROWS; r += NGW) {
        const bool isx = r < MROWS; const int v = isx ? (r >> 12) : 4;
        const float* xr = isx ? P.x + (size_t)r * DM : P.ctx + (size_t)(r - MROWS) * DM;
        bf16* orow = (bf16*)(ws + WS_H) + (size_t)r * DM;
        f32x4 xv[4]; float s = 0.f;
#pragma unroll
        for (int j = 0; j < 4; ++j) { xv[j] = *(const f32x4*)(xr + 4 * lane + 256 * j); s += (xv[j][0] * xv[j][0] + xv[j][1] * xv[j][1]) + (xv[j][2] * xv[j][2] + xv[j][3] * xv[j][3]); }
        const float rstd = 1.0f / sqrtf(wave_sum(s) * (1.0f / DM) + EPSN);
#pragma unroll
        for (int j = 0; j < 4; ++j) {
            const int c0 = 4 * lane + 256 * j;
            const f32x4 nw = *(const f32x4*)(P.norm_w + c0), sh = *(const f32x4*)(MOD + v * 3072 + c0), sc = *(const f32x4*)(MOD + v * 3072 + 1024 + c0);
            const f32x4 hv = (xv[j] * rstd) * nw * (sc + 1.0f) + sh;
            v2u w; w.x = cvtpk(hv[0], hv[1]); w.y = cvtpk(hv[2], hv[3]);
            *(v2u*)(orow + c0) = w;
        }
    }
    SEAM(1);

    if (IN(2)) {
        pg8::Gemm g{(const pg8::bf16_t*)(ws + WS_H), (const pg8::bf16_t*)(ws + WS_BT1), MROWS + MCROWS, N1, DM};
        Order1 S; S.init(G, (int)blockIdx.x);
        Epi1 E{LB, P.conv_w, (bf16*)P.out, (bf16*)P.out + (size_t)16 * MiB, (bf16*)(ws + WS_QEB), (bf16*)(ws + WS_KEB), (bf16*)(ws + WS_V),
               (bf16*)(ws + WS_CKEF), (bf16*)(ws + WS_CKEB), (bf16*)(ws + WS_CV), (bf16*)(ws + WS_YCAT),
               (float*)(ws + WS_DF), (float*)(ws + WS_DB), (float*)(ws + WS_CDF), (float*)(ws + WS_CDB)};
        pg8::gemm_phase<Epi1, Order1, false, true>(lds, g, S, E);
#if defined(REP_P2)
        __syncthreads(); pg8::gemm_phase<Epi1, Order1, false, true>(lds, g, S, E);
#endif
    }
    SEAM(2);

    if (IN(3)) scan_phase(P, lds, tid, wave, lane);
#if defined(REP_P3)
    if (IN(3)) { __syncthreads(); scan_phase(P, lds, tid, wave, lane); }
#endif
    SEAM(3);

    if (IN(4))
    for (int r = gw; r < MROWS; r += NGW) {
        const bf16* of = (const bf16*)(ws + WS_OF) + (size_t)r * DM + 16 * lane;
        const bf16* ob = (const bf16*)(ws + WS_OB) + (size_t)r * DM + 16 * lane;
        bf16* yc = (bf16*)(ws + WS_YCAT) + (size_t)r * MIXW + 16 * lane;
        const v4u f0 = *(const v4u*)of, f1 = *(const v4u*)(of + 8), b0 = *(const v4u*)ob, b1 = *(const v4u*)(ob + 8), g0 = *(const v4u*)yc, g1 = *(const v4u*)(yc + 8);
        float sv[16];
        sv[0] = bf_lo(f0.x) + bf_lo(b0.x); sv[1] = bf_hi(f0.x) + bf_hi(b0.x); sv[2] = bf_lo(f0.y) + bf_lo(b0.y); sv[3] = bf_hi(f0.y) + bf_hi(b0.y);
        sv[4] = bf_lo(f0.z) + bf_lo(b0.z); sv[5] = bf_hi(f0.z) + bf_hi(b0.z); sv[6] = bf_lo(f0.w) + bf_lo(b0.w); sv[7] = bf_hi(f0.w) + bf_hi(b0.w);
        sv[8] = bf_lo(f1.x) + bf_lo(b1.x); sv[9] = bf_hi(f1.x) + bf_hi(b1.x); sv[10] = bf_lo(f1.y) + bf_lo(b1.y); sv[11] = bf_hi(f1.y) + bf_hi(b1.y);
        sv[12] = bf_lo(f1.z) + bf_lo(b1.z); sv[13] = bf_hi(f1.z) + bf_hi(b1.z); sv[14] = bf_lo(f1.w) + bf_lo(b1.w); sv[15] = bf_hi(f1.w) + bf_hi(b1.w);
#if defined(DBG) && DBG == 3
        { const int bb = r >> 12, TT_ = r & 4095, hh = lane >> 3, k0 = (16 * lane) & 127;
          const size_t qo = ((size_t)(bb * 8 + hh) * 4096 + TT_) * 128 + k0;
          const bf16* a0 = (const bf16*)P.out + qo; const bf16* a1 = (const bf16*)P.out + (size_t)16 * MiB + qo;
          const bf16* a2 = (const bf16*)(ws + WS_QEB) + qo; const bf16* a3 = (const bf16*)(ws + WS_KEB) + qo; const bf16* a4 = (const bf16*)(ws + WS_V) + qo;
          const float* d0 = (const float*)(ws + WS_DF) + ((size_t)(bb * 8 + hh) * 64 + (TT_ >> 6)) * 128 + k0; const float* d1 = (const float*)(ws + WS_DB) + ((size_t)(bb * 8 + hh) * 64 + (TT_ >> 6)) * 128 + k0;
#pragma unroll
          for (int e = 0; e < 16; ++e) sv[e] = bf_lo(a0[e]) + 1e-3f * fminf(bf_lo(a1[e]), 1e3f) + bf_lo(a2[e]) + 1e-3f * fminf(bf_lo(a3[e]), 1e3f) + bf_lo(a4[e]) + d0[e] + d1[e]; }
#endif
#if defined(DBG) && DBG == 1
#pragma unroll
        for (int e = 0; e < 16; ++e) sv[e] = 0.25f;
#endif
        float ss = 0.f;
#pragma unroll
        for (int e = 0; e < 16; ++e) ss += sv[e] * sv[e];
        ss += __shfl_xor(ss, 1); ss += __shfl_xor(ss, 2); ss += __shfl_xor(ss, 4);
        const float rs = 1.0f / sqrtf(ss * (1.0f / 128.0f) + EPSN);
        const float* owp = P.onorm_w + ((16 * lane) & 127);
        const f32x4 w0 = *(const f32x4*)owp, w1 = *(const f32x4*)(owp + 4), w2 = *(const f32x4*)(owp + 8), w3 = *(const f32x4*)(owp + 12);
        float gt[16];
        gt[0] = bf_lo(g0.x); gt[1] = bf_hi(g0.x); gt[2] = bf_lo(g0.y); gt[3] = bf_hi(g0.y); gt[4] = bf_lo(g0.z); gt[5] = bf_hi(g0.z); gt[6] = bf_lo(g0.w); gt[7] = bf_hi(g0.w);
        gt[8] = bf_lo(g1.x); gt[9] = bf_hi(g1.x); gt[10] = bf_lo(g1.y); gt[11] = bf_hi(g1.y); gt[12] = bf_lo(g1.z); gt[13] = bf_hi(g1.z); gt[14] = bf_lo(g1.w); gt[15] = bf_hi(g1.w);
        float yv[16];
#pragma unroll
        for (int e = 0; e < 4; ++e) { yv[e] = sv[e] * rs * w0[e] * gt[e]; yv[4 + e] = sv[4 + e] * rs * w1[e] * gt[4 + e]; yv[8 + e] = sv[8 + e] * rs * w2[e] * gt[8 + e]; yv[12 + e] = sv[12 + e] * rs * w3[e] * gt[12 + e]; }
        v4u o0, o1;
        o0.x = cvtpk(yv[0], yv[1]); o0.y = cvtpk(yv[2], yv[3]); o0.z = cvtpk(yv[4], yv[5]); o0.w = cvtpk(yv[6], yv[7]);
        o1.x = cvtpk(yv[8], yv[9]); o1.y = cvtpk(yv[10], yv[11]); o1.z = cvtpk(yv[12], yv[13]); o1.w = cvtpk(yv[14], yv[15]);
        *(v4u*)yc = o0; *(v4u*)(yc + 8) = o1;
    }
    SEAM(4);

    if (IN(5)) {
        pg8::Gemm g{(const pg8::bf16_t*)(ws + WS_YCAT), (const pg8::bf16_t*)(ws + WS_BT2), MROWS, DM, MIXW};
        pg8::StaticOrder S; S.init(MROWS, DM, G, (int)blockIdx.x);
        Epi2 E{P.x, MOD, P.out};
        pg8::gemm_phase<Epi2, pg8::StaticOrder, false, true>(lds, g, S, E);
    }
    SEAM(5);

    if (IN(6))
    for (int r = gw; r < MROWS; r += NGW) {
        float* orow = P.out + (size_t)r * DM;
        f32x4 xv[4]; float s = 0.f;
#pragma unroll
        for (int j = 0; j < 4; ++j) { xv[j] = *(const f32x4*)(orow + 4 * lane + 256 * j); s += (xv[j][0] * xv[j][0] + xv[j][1] * xv[j][1]) + (xv[j][2] * xv[j][2] + xv[j][3] * xv[j][3]); }
        const float rstd = 1.0f / sqrtf(wave_sum(s) * (1.0f / DM) + EPSN);
#pragma unroll
        for (int j = 0; j < 4; ++j) { const f32x4 fw = *(const f32x4*)(P.fnorm_w + 4 * lane + 256 * j); *(f32x4*)(orow + 4 * lane + 256 * j) = (xv[j] * rstd) * fw; }
    }
}

extern "C" void kernel_launch(void* const* d_in, const int* in_sizes, int n_in, void* d_out, int out_size, void* d_ws, size_t ws_size, hipStream_t stream) {
    static int grid = 0;
    if (grid == 0) {
        int dev = 0, cus = 0, per_cu = 0;
        hipGetDevice(&dev); hipDeviceGetAttribute(&cus, hipDeviceAttributeMultiprocessorCount, dev);
        if (hipFuncSetAttribute((const void*)fwd_megakernel, hipFuncAttributeMaxDynamicSharedMemorySize, LDS_BYTES) != hipSuccess) { fprintf(stderr, "kernel_launch: hipFuncSetAttribute failed\n"); }
        if (hipOccupancyMaxActiveBlocksPerMultiprocessor(&per_cu, (const void*)fwd_megakernel, 512, LDS_BYTES) != hipSuccess || per_cu < 1) { fprintf(stderr, "kernel_launch: occupancy query gave %d\n", per_cu); per_cu = 1; }
        (void)hipGetLastError();
        grid = cus * per_cu; if (grid > 256) grid = 256; if (grid < 1) grid = 1;
        if (ws_size < WS_END) fprintf(stderr, "kernel_launch: workspace too small: %zu < %zu\n", ws_size, (size_t)WS_END);
    }
    Params p{};
    p.x = (const float*)d_in[0]; p.c = (const float*)d_in[1]; p.ctx = (const float*)d_in[2]; p.c_ctx = (const float*)d_in[3]; p.norm_w = (const float*)d_in[4];
    p.w_ada = (const float*)d_in[5]; p.b_ada = (const float*)d_in[6]; p.w_in = (const float*)d_in[7]; p.lb_logits = (const float*)d_in[8]; p.onorm_w = (const float*)d_in[9];
    p.conv_w = (const float*)d_in[10]; p.w_out = (const float*)d_in[11]; p.fnorm_w = (const float*)d_in[12];
    p.out = (float*)d_out; p.ws = (unsigned char*)d_ws;
#ifndef N_LAUNCH
#define N_LAUNCH 1
#endif
    if (N_LAUNCH == 1) {
        (void)hipMemsetAsync((char*)d_ws + WS_CTL, 0, 16384, stream);
        p.ph_lo = 0; p.ph_hi = 7;
        void* args[] = {&p};
        hipError_t e = hipLaunchCooperativeKernel((const void*)fwd_megakernel, dim3(grid), dim3(512), args, LDS_BYTES, stream);
        if (e != hipSuccess) fprintf(stderr, "cooperative launch failed: %s (grid %d)\n", hipGetErrorString(e), grid);
    } else {
        for (int k = 0; k < 7; ++k) { p.ph_lo = k; p.ph_hi = k + 1; hipLaunchKernelGGL(fwd_megakernel, dim3(grid), dim3(512), LDS_BYTES, stream, p); }
    }
}
```
